# Optimizing an MI355X kernel written in HIP

```python
import numpy as np
import jax
import jax.numpy as jnp
from jax import lax

D_MODEL = 2048
BATCH = 4
SEQ = 2048
DEPTH = 2

MEM_LEN = 256
POS_OFFSET_MAX = 4096
ROPE_THETA = 500000.0
RMS_EPS = 1e-6
NEG_INF = -1e30
FORCE_SCORE = 1e4
Q_BLOCK = 128

MLA_HEADS = 8
MLA_NOPE = 128
MLA_ROPE = 64
MLA_V = 128
MLA_Q_RANK = D_MODEL // 4
MLA_KV_RANK = D_MODEL // 8

NSA_HEADS = 8
NSA_KV_GROUPS = 2
NSA_HPG = NSA_HEADS // NSA_KV_GROUPS
NSA_DK = 128
NSA_DV = 128
NSA_ROT = NSA_DK // 4
CMP_LEN = 32
CMP_STRIDE = 16
CMP_HID = 4 * NSA_DK
SEL_BLOCK = 64
SEL_TOPN = 8
WINDOW = 512
N_BRANCH = 3

D_MIX = MLA_HEADS * MLA_V + NSA_HEADS * NSA_DV
KV_WK = NSA_KV_GROUPS * NSA_DK
KV_WV = NSA_KV_GROUPS * NSA_DV
IN_SIZES = (MLA_Q_RANK, MLA_KV_RANK, MLA_ROPE, NSA_HEADS * NSA_DK, KV_WK, KV_WV, KV_WK, KV_WV, KV_WK, KV_WV, NSA_HEADS * N_BRANCH)
D_IN = MLA_Q_RANK + MLA_KV_RANK + MLA_ROPE + NSA_HEADS * NSA_DK + 3 * KV_WK + 3 * KV_WV + NSA_HEADS * N_BRANCH

XATTN_HEADS = 4
XATTN_HD = 128

N_GROUPS = 8
EXP_PER_GROUP = 8
N_EXPERTS = N_GROUPS * EXP_PER_GROUP
TOP_K = 2
D_EXPERT = D_MODEL // 4
MOE_BLOCK = 128

kernel_name = 'hybrid_mla_nsa_hier_moe_block'


def rms_norm(x, g):
    xf = x.astype(jnp.float32)
    xf = xf * lax.rsqrt(jnp.mean(xf * xf, axis=-1, keepdims=True) + RMS_EPS)
    return (xf * g.astype(jnp.float32)).astype(x.dtype)


def rope_angles(positions, rot_dim):
    inv_freq = ROPE_THETA ** (-jnp.arange(0, rot_dim, 2, dtype=jnp.float32) / rot_dim)
    ang = positions.astype(jnp.float32)[..., None] * inv_freq
    return jnp.cos(ang), jnp.sin(ang)


def apply_rope(x, cos, sin):
    half = cos.shape[-1]
    xf = x[..., :2 * half].astype(jnp.float32)
    x1, x2 = xf[..., :half], xf[..., half:]
    rot = jnp.concatenate([x1 * cos - x2 * sin, x2 * cos + x1 * sin], axis=-1).astype(x.dtype)
    return jnp.concatenate([rot, x[..., 2 * half:]], axis=-1)


def masked_softmax(s, mask):
    s = jnp.where(mask, s.astype(jnp.float32), NEG_INF)
    return jnp.where(mask, jax.nn.softmax(s, axis=-1), 0.0)


def mla(c_q, c_kv, k_r, cos, sin, g_cq, w_uq, g_ckv, w_ukv):
    b, s, _ = c_q.shape
    q = (rms_norm(c_q, g_cq) @ w_uq).reshape(b, s, MLA_HEADS, MLA_NOPE + MLA_ROPE)
    q = jnp.concatenate([q[..., :MLA_NOPE], apply_rope(q[..., MLA_NOPE:], cos[:, :, None], sin[:, :, None])], axis=-1)
    kv = (rms_norm(c_kv, g_ckv) @ w_ukv).reshape(b, s, MLA_HEADS, MLA_NOPE + MLA_V)
    k_nope, v = kv[..., :MLA_NOPE], kv[..., MLA_NOPE:]
    k_rope = apply_rope(k_r, cos, sin)
    k = jnp.concatenate([k_nope, jnp.broadcast_to(k_rope[:, :, None, :], (b, s, MLA_HEADS, MLA_ROPE))], axis=-1)
    scale = (MLA_NOPE + MLA_ROPE) ** -0.5
    nqb = s // Q_BLOCK
    qb = q.reshape(b, nqb, Q_BLOCK, MLA_HEADS, MLA_NOPE + MLA_ROPE).transpose(1, 0, 2, 3, 4)
    kpos = jnp.arange(s)

    def q_block(args):
        i, qi = args
        sc = jnp.einsum('bqhd,bkhd->bhqk', qi, k) * scale
        qpos = i * Q_BLOCK + jnp.arange(Q_BLOCK)
        p = masked_softmax(sc, kpos[None, :] <= qpos[:, None]).astype(v.dtype)
        return jnp.einsum('bhqk,bkhd->bqhd', p, v)

    o = lax.map(q_block, (jnp.arange(nqb), qb))
    return o.transpose(1, 0, 2, 3, 4).reshape(b, s, MLA_HEADS * MLA_V)


def nsa(q, k_c, v_c, k_s, v_s, k_w, v_w, gate_logits, cos, sin, pe_k, pe_v, w_ck1, w_ck2, w_cv1, w_cv2):
    b, s, _ = q.shape
    G, HPG = NSA_KV_GROUPS, NSA_HPG
    q = apply_rope(q.reshape(b, s, G, HPG, NSA_DK), cos[:, :, None, None], sin[:, :, None, None])

    def keys(t):
        return apply_rope(t.reshape(b, s, G, NSA_DK), cos[:, :, None], sin[:, :, None])

    def vals(t):
        return t.reshape(b, s, G, NSA_DV)

    k_c, k_s, k_w = keys(k_c), keys(k_s), keys(k_w)
    v_c, v_s, v_w = vals(v_c), vals(v_s), vals(v_w)
    scale = NSA_DK ** -0.5
    pos = np.arange(s)

    nc = (s - CMP_LEN) // CMP_STRIDE + 1
    cidx = np.arange(nc)[:, None] * CMP_STRIDE + np.arange(CMP_LEN)[None, :]

    def compress(t, pe, w1, w2):
        blk = t[:, cidx] + pe[:, None, :]
        blk = blk.transpose(0, 1, 3, 2, 4).reshape(b, nc, G, CMP_LEN * t.shape[-1])
        return jax.nn.gelu(blk @ w1) @ w2

    kc = compress(k_c, pe_k, w_ck1, w_ck2)
    vc = compress(v_c, pe_v, w_cv1, w_cv2)
    s_c = jnp.einsum('bsghd,bcgd->bghsc', q, kc) * scale
    cmp_end = np.arange(nc) * CMP_STRIDE + CMP_LEN - 1
    p_c = masked_softmax(s_c, cmp_end[None, :] <= pos[:, None])
    o_c = jnp.einsum('bghsc,bcgd->bsghd', p_c.astype(vc.dtype), vc)

    ns = s // SEL_BLOCK
    sel_start = np.arange(ns) * SEL_BLOCK
    c_start = np.arange(nc)[:, None] * CMP_STRIDE
    overlap = ((c_start <= sel_start[None, :] + SEL_BLOCK - 1) & (c_start + CMP_LEN - 1 >= sel_start[None, :])).astype(np.float32)
    imp = jnp.einsum('bghsc,cn->bgsn', p_c, overlap)
    forced = (sel_start[None, :] == 0) | (sel_start[None, :] == (pos[:, None] // SEL_BLOCK) * SEL_BLOCK)
    visible = sel_start[None, :] <= pos[:, None]
    imp = jnp.where(forced, FORCE_SCORE, jnp.where(visible, imp, -FORCE_SCORE))
    n_top = min(SEL_TOPN, ns)
    _, sel_idx = lax.top_k(imp, n_top)

    ks_blk = k_s.reshape(b, ns, SEL_BLOCK, G, NSA_DK).transpose(0, 3, 1, 2, 4)
    vs_blk = v_s.reshape(b, ns, SEL_BLOCK, G, NSA_DV).transpose(0, 3, 1, 2, 4)
    nqb = s // Q_BLOCK
    q_b = q.reshape(b, nqb, Q_BLOCK, G, HPG, NSA_DK).transpose(1, 0, 3, 2, 4, 5)
    idx_b = sel_idx.reshape(b, G, nqb, Q_BLOCK, n_top).transpose(2, 0, 1, 3, 4)
    gather = jax.vmap(jax.vmap(lambda blocks, ids: blocks[ids]))

    def sel_block(args):
        i, qi, ii = args
        kg = gather(ks_blk, ii)
        vg = gather(vs_blk, ii).reshape(b, G, Q_BLOCK, n_top * SEL_BLOCK, NSA_DV)
        sc = jnp.einsum('bgqhd,bgqnkd->bgqhnk', qi, kg).reshape(b, G, Q_BLOCK, HPG, n_top * SEL_BLOCK) * scale
        qpos = i * Q_BLOCK + jnp.arange(Q_BLOCK)
        kpos = ii[..., None] * SEL_BLOCK + jnp.arange(SEL_BLOCK)
        mask = (kpos <= qpos[None, None, :, None, None]).reshape(b, G, Q_BLOCK, 1, n_top * SEL_BLOCK)
        p = masked_softmax(sc, mask).astype(vg.dtype)
        return jnp.einsum('bgqhk,bgqkd->bqghd', p, vg)

    o_s = lax.map(sel_block, (jnp.arange(nqb), q_b, idx_b))
    o_s = o_s.transpose(1, 0, 2, 3, 4, 5).reshape(b, s, G, HPG, NSA_DV)

    nwb = WINDOW // Q_BLOCK
    bidx = np.arange(nqb)[:, None] + np.arange(nwb + 1)[None, :]

    def band(t):
        tp = jnp.pad(t, ((0, 0), (WINDOW, 0), (0, 0), (0, 0))).reshape(b, nqb + nwb, Q_BLOCK, G, t.shape[-1])
        return tp[:, bidx].reshape(b, nqb, (nwb + 1) * Q_BLOCK, G, t.shape[-1])

    kw, vw = band(k_w), band(v_w)
    qw = q.reshape(b, nqb, Q_BLOCK, G, HPG, NSA_DK)
    s_w = jnp.einsum('bnqghd,bnkgd->bnghqk', qw, kw) * scale
    qpos = np.arange(nqb)[:, None] * Q_BLOCK + np.arange(Q_BLOCK)[None, :]
    kpos = np.arange(nqb)[:, None] * Q_BLOCK - WINDOW + np.arange((nwb + 1) * Q_BLOCK)[None, :]
    dist = qpos[:, :, None] - kpos[:, None, :]
    mask_w = (dist >= 0) & (dist < WINDOW) & (kpos[:, None, :] >= 0)
    p_w = masked_softmax(s_w, mask_w[None, :, None, None]).astype(vw.dtype)
    o_w = jnp.einsum('bnghqk,bnkgd->bnqghd', p_w, vw).reshape(b, s, G, HPG, NSA_DV)

    g = jax.nn.sigmoid(gate_logits.astype(jnp.float32)).reshape(b, s, G, HPG, N_BRANCH).astype(o_c.dtype)
    o = g[..., 0:1] * o_c + g[..., 1:2] * o_s + g[..., 2:3] * o_w
    return o.reshape(b, s, NSA_HEADS * NSA_DV)


def hybrid_mixer(h, cos_a, sin_a, cos_n, sin_n, w_in, g_cq, w_uq, g_ckv, w_ukv, pe_k, pe_v, w_ck1, w_ck2, w_cv1, w_cv2, g_ya, g_yb, w_out):
    proj = h @ w_in
    cuts = np.cumsum(IN_SIZES)[:-1].tolist()
    c_q, c_kv, k_r, q_n, k_c, v_c, k_s, v_s, k_w, v_w, gate_logits = jnp.split(proj, cuts, axis=-1)
    y_a = mla(c_q, c_kv, k_r, cos_a, sin_a, g_cq, w_uq, g_ckv, w_ukv)
    y_b = nsa(q_n, k_c, v_c, k_s, v_s, k_w, v_w, gate_logits, cos_n, sin_n, pe_k, pe_v, w_ck1, w_ck2, w_cv1, w_cv2)
    y = jnp.concatenate([rms_norm(y_a, g_ya), rms_norm(y_b, g_yb)], axis=-1)
    return y @ w_out


def mem_cross_attn(h, mem_n, w_xq, w_xkv, w_xo):
    b, s, _ = h.shape
    m = mem_n.shape[1]
    q = (h @ w_xq).reshape(b, s, XATTN_HEADS, XATTN_HD)
    kv = (mem_n @ w_xkv).reshape(b, m, 2, XATTN_HEADS, XATTN_HD)
    k, v = kv[:, :, 0], kv[:, :, 1]
    sc = jnp.einsum('bshd,bmhd->bhsm', q, k) * (XATTN_HD ** -0.5)
    p = jax.nn.softmax(sc.astype(jnp.float32), axis=-1).astype(v.dtype)
    o = jnp.einsum('bhsm,bmhd->bshd', p, v).reshape(b, s, XATTN_HEADS * XATTN_HD)
    return o @ w_xo


def hier_moe(h, w_grp, b_grp, w_exp, b_exp, w_e1, w_e3, w_e2):
    b, s, d = h.shape
    n_tok = b * s
    xt = h.reshape(n_tok, d)
    p_grp = jax.nn.softmax((xt @ w_grp + b_grp).astype(jnp.float32), axis=-1)
    grp = jnp.argmax(p_grp, axis=-1).astype(jnp.int32)
    p_top_grp = jnp.take_along_axis(p_grp, grp[:, None], axis=-1)
    e_logits = (xt @ w_exp + b_exp).astype(jnp.float32).reshape(n_tok, N_GROUPS, EXP_PER_GROUP)
    in_grp = jnp.take_along_axis(e_logits, grp[:, None, None], axis=1)[:, 0]
    top_val, top_idx = lax.top_k(in_grp, TOP_K)
    gate = (p_top_grp * jax.nn.softmax(top_val, axis=-1)).reshape(-1)
    expert = (grp[:, None] * EXP_PER_GROUP + top_idx).reshape(-1).astype(jnp.int32)
    tok = jnp.repeat(jnp.arange(n_tok, dtype=jnp.int32), TOP_K)
    onehot = jax.nn.one_hot(expert, N_EXPERTS, dtype=jnp.int32)
    rank = jnp.take_along_axis(jnp.cumsum(onehot, axis=0), expert[:, None], axis=1)[:, 0] - 1
    counts = jnp.sum(onehot, axis=0)
    padded = (counts + MOE_BLOCK - 1) // MOE_BLOCK * MOE_BLOCK
    pad_end = jnp.cumsum(padded)
    pad_start = pad_end - padded
    dest = pad_start[expert] + rank
    n_assign = n_tok * TOP_K
    n_blocks = (n_assign + N_EXPERTS * (MOE_BLOCK - 1) + MOE_BLOCK - 1) // MOE_BLOCK
    n_slots = n_blocks * MOE_BLOCK
    slot_tok = jnp.zeros((n_slots,), jnp.int32).at[dest].set(tok)
    slot_gate = jnp.zeros((n_slots,), jnp.float32).at[dest].set(gate)
    blk_start = jnp.arange(n_blocks, dtype=jnp.int32) * MOE_BLOCK
    blk_expert = jnp.clip(jnp.searchsorted(pad_end, blk_start, side='right'), 0, N_EXPERTS - 1)

    def expert_block(args):
        e_id, toks = args
        xb = xt[toks]
        hb = jax.nn.silu(xb @ w_e1[e_id]) * (xb @ w_e3[e_id])
        return hb @ w_e2[e_id]

    yb = lax.map(expert_block, (blk_expert, slot_tok.reshape(n_blocks, MOE_BLOCK)))
    yb = yb.reshape(n_slots, d) * slot_gate[:, None].astype(h.dtype)
    y = jnp.zeros((n_tok, d), h.dtype).at[slot_tok].add(yb)
    return y.reshape(b, s, d)


def setup_inputs(seed: int = 0) -> dict:
    key = jax.random.key(seed)
    ks = jax.random.split(key, 40)
    f32 = jnp.float32
    L = DEPTH

    def nrm(k, shape, fan_in):
        return jax.random.normal(k, shape, f32) * (fan_in ** -0.5)

    def gain(k, shape):
        return 1.0 + 0.02 * jax.random.normal(k, shape, f32)

    x = jax.random.normal(ks[0], (BATCH, SEQ, D_MODEL), f32)
    mem = jax.random.normal(ks[1], (BATCH, MEM_LEN, D_MODEL), f32)
    positions = jax.random.randint(ks[2], (BATCH, 1), 0, POS_OFFSET_MAX, dtype=jnp.int32) + jnp.arange(SEQ, dtype=jnp.int32)[None, :]
    return {
        'x': x,
        'mem': mem,
        'positions': positions,
        'g_mem': gain(ks[3], (D_MODEL,)),
        'g_final': gain(ks[4], (D_MODEL,)),
        'g_mix': gain(ks[5], (L, D_MODEL)),
        'w_in': nrm(ks[6], (L, D_MODEL, D_IN), D_MODEL),
        'g_cq': gain(ks[7], (L, MLA_Q_RANK)),
        'w_uq': nrm(ks[8], (L, MLA_Q_RANK, MLA_HEADS * (MLA_NOPE + MLA_ROPE)), MLA_Q_RANK),
        'g_ckv': gain(ks[9], (L, MLA_KV_RANK)),
        'w_ukv': nrm(ks[10], (L, MLA_KV_RANK, MLA_HEADS * (MLA_NOPE + MLA_V)), MLA_KV_RANK),
        'pe_k': 0.1 * jax.random.normal(ks[11], (L, CMP_LEN, NSA_DK), f32),
        'pe_v': 0.1 * jax.random.normal(ks[12], (L, CMP_LEN, NSA_DV), f32),
        'w_ck1': nrm(ks[13], (L, CMP_LEN * NSA_DK, CMP_HID), CMP_LEN * NSA_DK),
        'w_ck2': nrm(ks[14], (L, CMP_HID, NSA_DK), CMP_HID),
        'w_cv1': nrm(ks[15], (L, CMP_LEN * NSA_DV, CMP_HID), CMP_LEN * NSA_DV),
        'w_cv2': nrm(ks[16], (L, CMP_HID, NSA_DV), CMP_HID),
        'g_ya': gain(ks[17], (L, MLA_HEADS * MLA_V)),
        'g_yb': gain(ks[18], (L, NSA_HEADS * NSA_DV)),
        'w_out': nrm(ks[19], (L, D_MIX, D_MODEL), D_MIX),
        'g_x': gain(ks[20], (L, D_MODEL)),
        'w_xq': nrm(ks[21], (L, D_MODEL, XATTN_HEADS * XATTN_HD), D_MODEL),
        'w_xkv': nrm(ks[22], (L, D_MODEL, 2 * XATTN_HEADS * XATTN_HD), D_MODEL),
        'w_xo': nrm(ks[23], (L, XATTN_HEADS * XATTN_HD, D_MODEL), XATTN_HEADS * XATTN_HD),
        'g_ffn': gain(ks[24], (L, D_MODEL)),
        'w_grp': nrm(ks[25], (L, D_MODEL, N_GROUPS), D_MODEL),
        'b_grp': 0.01 * jax.random.normal(ks[26], (L, N_GROUPS), f32),
        'w_exp': nrm(ks[27], (L, D_MODEL, N_EXPERTS), D_MODEL),
        'b_exp': 0.01 * jax.random.normal(ks[28], (L, N_EXPERTS), f32),
        'w_e1': nrm(ks[29], (L, N_EXPERTS, D_MODEL, D_EXPERT), D_MODEL),
        'w_e3': nrm(ks[30], (L, N_EXPERTS, D_MODEL, D_EXPERT), D_MODEL),
        'w_e2': nrm(ks[31], (L, N_EXPERTS, D_EXPERT, D_MODEL), D_EXPERT),
    }


def reference(x, mem, positions, g_mem, g_final, g_mix, w_in, g_cq, w_uq, g_ckv, w_ukv, pe_k, pe_v, w_ck1, w_ck2, w_cv1, w_cv2, g_ya, g_yb, w_out, g_x, w_xq, w_xkv, w_xo, g_ffn, w_grp, b_grp, w_exp, b_exp, w_e1, w_e3, w_e2):
    cos_a, sin_a = rope_angles(positions, MLA_ROPE)
    cos_n, sin_n = rope_angles(positions, NSA_ROT)
    mem_n = rms_norm(mem, g_mem)
    h = x
    for l in range(DEPTH):
        h = h + hybrid_mixer(rms_norm(h, g_mix[l]), cos_a, sin_a, cos_n, sin_n, w_in[l], g_cq[l], w_uq[l], g_ckv[l], w_ukv[l], pe_k[l], pe_v[l], w_ck1[l], w_ck2[l], w_cv1[l], w_cv2[l], g_ya[l], g_yb[l], w_out[l])
        h = h + mem_cross_attn(rms_norm(h, g_x[l]), mem_n, w_xq[l], w_xkv[l], w_xo[l])
        h = h + hier_moe(rms_norm(h, g_ffn[l]), w_grp[l], b_grp[l], w_exp[l], b_exp[l], w_e1[l], w_e3[l], w_e2[l])
    return rms_norm(h, g_final)
```

```cpp
#include <hip/hip_runtime.h>
#include <hip/hip_bf16.h>
#include <stdint.h>
#include <stdio.h>
#include <math.h>
#include <stddef.h>

typedef __hip_bfloat16 bf16;
typedef short bf16x8 __attribute__((ext_vector_type(8)));
typedef short s16x4 __attribute__((ext_vector_type(4)));
typedef float f32x16 __attribute__((ext_vector_type(16)));
typedef float f32x4 __attribute__((ext_vector_type(4)));
typedef float f32x2 __attribute__((ext_vector_type(2)));
typedef unsigned u32x4 __attribute__((ext_vector_type(4)));
typedef unsigned u32x2 __attribute__((ext_vector_type(2)));

#ifndef MK_FUSED
#define MK_FUSED 1
#endif
#ifndef ATT_PIPE2
#define ATT_PIPE2 1
#endif
#ifndef PROBE_MASK
#define PROBE_MASK 0
#endif
#ifndef PROBE_VAR
#define PROBE_VAR 0
#endif
#ifndef PROBE_BAR2
#define PROBE_BAR2 0
#endif

constexpr int NB = 4, S = 2048, T = NB * S, DM = 2048, DEPTH = 2;
constexpr int DIN = 3416, DINP = 3584;
constexpr int C_CQ = 0, C_CKV = 512, C_KR = 768, C_QN = 832, C_KC = 1856, C_VC = 2112, C_KS = 2368, C_VS = 2624, C_KW = 2880, C_VW = 3136, C_GT = 3392;
constexpr int NCMP = 127, CMP_ROWS = NB * 2 * NCMP;
constexpr int NEXP = 64, ECAP = 8192, NASG = T * 2;
constexpr int NTHR = 512;

constexpr size_t al256(size_t x) { return (x + 255) / 256 * 256; }
constexpr size_t WS_CTL = 0;
constexpr size_t CTL_BYTES = 32768;
constexpr size_t CTL_CNT = 16384;
constexpr size_t CTL_Q = 16384 + 1024;
constexpr size_t CTL_XQ = 16384 + 2048;
constexpr size_t WS_H = WS_CTL + CTL_BYTES;
constexpr size_t WS_XN = WS_H + (size_t)T * DM * 4;
constexpr size_t WS_PROJ = WS_XN + (size_t)T * DM * 2;
constexpr size_t WS_CQN = WS_PROJ + (size_t)T * DINP * 4;
constexpr size_t WS_CKVN = WS_CQN + (size_t)T * 512 * 2;
constexpr size_t WS_QMLA = WS_CKVN + (size_t)T * 256 * 2;
constexpr size_t WS_KMLA = WS_QMLA + (size_t)T * 1536 * 2;
constexpr size_t WS_VMLA = WS_KMLA + (size_t)T * 1536 * 2;
constexpr size_t WS_QN = WS_VMLA + (size_t)T * 1024 * 2;
constexpr size_t WS_KV6 = WS_QN + (size_t)T * 1024 * 2;
constexpr size_t KV6_STRIDE = (size_t)T * 256;
constexpr size_t WS_GATES = WS_KV6 + 6 * KV6_STRIDE * 2;
constexpr size_t WS_COSA = WS_GATES + (size_t)T * 24 * 4;
constexpr size_t WS_SINA = WS_COSA + (size_t)T * 32 * 4;
constexpr size_t WS_COSN = WS_SINA + (size_t)T * 32 * 4;
constexpr size_t WS_SINN = WS_COSN + (size_t)T * 16 * 4;
constexpr size_t WS_MEMN = WS_SINN + (size_t)T * 16 * 4;
constexpr size_t WS_KVX = WS_MEMN + (size_t)1024 * 2048 * 2;
constexpr size_t WS_BIAS1 = WS_KVX + (size_t)2 * 1024 * 1024 * 2;
constexpr size_t WS_HID = WS_BIAS1 + 2 * 2 * 512 * 4;
constexpr size_t WS_KCMP = WS_HID + (size_t)2 * 1024 * 512 * 2;
constexpr size_t WS_YMLA = WS_KCMP + (size_t)2 * 8 * 128 * 128 * 2;
constexpr size_t WS_YNSA = WS_YMLA + (size_t)T * 1024 * 2;
constexpr size_t WS_Y = WS_YNSA + (size_t)T * 1024 * 4;
constexpr size_t WS_QX = WS_Y + (size_t)T * 2048 * 2;
constexpr size_t WS_OX = WS_QX + (size_t)T * 512 * 2;
constexpr size_t WS_TOKE = WS_OX + (size_t)T * 512 * 2;
constexpr size_t WS_TOKR = WS_TOKE + (size_t)T * 2 * 4;
constexpr size_t WS_ELIST = WS_TOKR + (size_t)T * 2 * 4;
constexpr size_t WS_EGATE = WS_ELIST + (size_t)NEXP * ECAP * 4;
constexpr size_t WS_HBUF = WS_EGATE + (size_t)NEXP * ECAP * 4;
constexpr size_t WS_YBUF = WS_HBUF + (size_t)NASG * 512 * 2;
constexpr size_t WS_WT = WS_YBUF + (size_t)NASG * 2048 * 2;
constexpr size_t WT_IN = 0, WT_OUT = WT_IN + (size_t)DINP * DM, WT_UQ = WT_OUT + (size_t)DM * DM, WT_UKV = WT_UQ + (size_t)1536 * 512,
                 WT_XO = WT_UKV + (size_t)2048 * 256, WT_LAYER = WT_XO + (size_t)DM * 512;
constexpr size_t WS_SSQ = WS_WT + 2 * WT_LAYER * 2;
constexpr size_t WS_HSSQ = WS_SSQ + (size_t)T * 16 * 4;
constexpr size_t WS_YSSQ = WS_HSSQ + (size_t)T * 32 * 4;
constexpr size_t WS_HB = WS_YSSQ + (size_t)T * 16 * 4;
constexpr size_t WS_EINV = WS_HB + (size_t)T * DM * 2;
constexpr size_t WS_B1PART = WS_EINV + (size_t)NEXP * ECAP * 4;
constexpr size_t WS_CMP1P = WS_B1PART + 4 * 16 * 512 * 4;
constexpr size_t WS_END = WS_CMP1P + (size_t)4 * 2 * 1024 * 512 * 4;

constexpr int L_TOP = 147456;
constexpr int LDS_BYTES = L_TOP + 4096;
constexpr int L_YSC = L_TOP + 2048;
constexpr int L_RINV = L_TOP + 1280;
constexpr int SHM_V = 64 * 128 * 2;
constexpr int SHM_KMAX = 64 * 192 * 2;
constexpr int L_V = 0, L_K = 2 * SHM_V, L_WS = L_K + 2 * SHM_KMAX;
constexpr int L_OV = L_WS + 8 * 512;
constexpr int L_IMP = L_OV + 8192;
constexpr int L_SELM = L_IMP + 33792;
constexpr int L_TL = L_SELM + 256;
constexpr int L_MISC = L_TOP;
constexpr int L_PFX = L_MISC + 256;
static_assert(L_TL + 160 <= 131072 && L_PFX + 1024 <= LDS_BYTES, "lds");

#define XB_TMO      128
#define XB_XCNT(j)  (256  + 64 * (j))
#define XB_XSUB(j)  (1280 + 64 * (j))
#define XB_XGEN(j)  (2304 + 64 * (j))
#define XB_TOP      3328
#define XB_TOPGEN   3392
#define XCD_BAR_WORDS 3456
#define XB_SPIN_CAP (1u << 22)
#define LAS __attribute__((address_space(3)))
__device__ __forceinline__ unsigned xb_ld(unsigned* p)              { return __hip_atomic_load(p, __ATOMIC_RELAXED, __HIP_MEMORY_SCOPE_AGENT); }
__device__ __forceinline__ unsigned xb_add(unsigned* p, unsigned v) { return __hip_atomic_fetch_add(p, v, __ATOMIC_RELAXED, __HIP_MEMORY_SCOPE_AGENT); }
__device__ __forceinline__ unsigned xb_xcc_id() { return (unsigned)__builtin_amdgcn_s_getreg((3 << 11) | 20) & 0xFu; }
#define XB_SPIN(cond, bar) do { unsigned _sp = 0; while (cond) { __builtin_amdgcn_s_sleep(1); \
    if ((++_sp & 255u) == 0u) { if (xb_ld(&(bar)[XB_TMO])) break; if (_sp > XB_SPIN_CAP) { atomicAdd(&(bar)[XB_TMO], 1u); break; } } } } while (0)
struct XcdBarrier { unsigned* bar; unsigned x; volatile LAS unsigned* st; };
__device__ __forceinline__ XcdBarrier xcd_barrier_post(unsigned* bar, volatile LAS unsigned* st) {
    XcdBarrier b; b.bar = bar; b.x = xb_xcc_id(); b.st = st;
    if (threadIdx.x == 0) (void)xb_add(&bar[XB_XCNT(b.x)], 1u);
    return b;
}
__device__ __forceinline__ void xcd_barrier_complete(unsigned* bar, unsigned x, unsigned& nloc, unsigned& nx) {
    const unsigned G = gridDim.x * gridDim.y * gridDim.z;
    unsigned sum, cnt, mine, sp = 0u;
    for (;;) {
        sum = 0u; cnt = 0u; mine = 0u;
#pragma unroll
        for (unsigned j = 0; j < 16; ++j) { const unsigned c = xb_ld(&bar[XB_XCNT(j)]); sum += c; cnt += (c > 0u) ? 1u : 0u; mine = (j == x) ? c : mine; }
        if (sum == G) break;
        __builtin_amdgcn_s_sleep(1);
        if ((++sp & 255u) == 0u) { if (xb_ld(&bar[XB_TMO])) break; if (sp > XB_SPIN_CAP) { atomicAdd(&bar[XB_TMO], 1u); break; } }
    }
    nloc = mine > 0u ? mine : 1u; nx = cnt > 0u ? cnt : 1u;
}
__device__ __forceinline__ void xcd_barrier(const XcdBarrier& b) {
    asm volatile("s_waitcnt vmcnt(0)" ::: "memory");
    __syncthreads();
    if (threadIdx.x == 0) {
        unsigned* bar = b.bar;
        __builtin_amdgcn_s_waitcnt(0);
        unsigned nloc = b.st[0], nx = b.st[1];
        if (nloc == 0u) { xcd_barrier_complete(bar, b.x, nloc, nx); b.st[0] = nloc; b.st[1] = nx; }
        const unsigned old = xb_add(&bar[XB_XSUB(b.x)], 1u);
        const unsigned gen = old / nloc;
        if (old + 1u == (gen + 1u) * nloc) {
            __builtin_amdgcn_fence(__ATOMIC_RELEASE, "agent");
            asm volatile("s_waitcnt vmcnt(0)" ::: "memory");
            const unsigned og = xb_add(&bar[XB_TOP], 1u);
            const unsigned tg = og / nx;
            if (og + 1u == (tg + 1u) * nx) xb_add(&bar[XB_TOPGEN], 1u);
            else XB_SPIN(xb_ld(&bar[XB_TOPGEN]) == tg, bar);
            __builtin_amdgcn_fence(__ATOMIC_ACQUIRE, "agent");
            xb_add(&bar[XB_XGEN(b.x)], 1u);
            asm volatile("s_waitcnt vmcnt(0)" ::: "memory");
        } else {
            XB_SPIN(xb_ld(&bar[XB_XGEN(b.x)]) == gen, bar);
            __builtin_amdgcn_fence(__ATOMIC_ACQUIRE, "agent");
            asm volatile("s_waitcnt vmcnt(0)" ::: "memory");
        }
    }
    __syncthreads();
}

struct Params {
    const float *x, *mem; const int* positions;
    const float *g_mem, *g_final, *g_mix, *w_in, *g_cq, *w_uq, *g_ckv, *w_ukv, *pe_k, *pe_v, *w_ck1, *w_ck2, *w_cv1, *w_cv2,
                *g_ya, *g_yb, *w_out, *g_x, *w_xq, *w_xkv, *w_xo, *g_ffn, *w_grp, *b_grp, *w_exp, *b_exp, *w_e1, *w_e3, *w_e2;
    float* out; unsigned char* ws;
    int ph_lo, ph_hi;
};
#define PFIELDS(X) X(x) X(mem) X(positions) X(g_mem) X(g_final) X(g_mix) X(w_in) X(g_cq) X(w_uq) X(g_ckv) X(w_ukv) X(pe_k) X(pe_v) X(w_ck1) X(w_ck2) \
    X(w_cv1) X(w_cv2) X(g_ya) X(g_yb) X(w_out) X(g_x) X(w_xq) X(w_xkv) X(w_xo) X(g_ffn) X(w_grp) X(b_grp) X(w_exp) X(b_exp) X(w_e1) X(w_e3) X(w_e2) X(out) X(ws)
__device__ __forceinline__ int TID() { int t = threadIdx.x; asm volatile("" : "+v"(t)); return t; }
#define SBAR() __builtin_amdgcn_sched_barrier(0)
__device__ __forceinline__ unsigned cvtpk(float lo, float hi) {
    unsigned r; asm volatile("v_cvt_pk_bf16_f32 %0, %1, %2" : "=v"(r) : "v"(lo), "v"(hi)); return r;
}
__device__ __forceinline__ float bf2f(unsigned short v) { return __uint_as_float(((unsigned)v) << 16); }
__device__ __forceinline__ float bflo(unsigned w) { return __uint_as_float(w << 16); }
__device__ __forceinline__ float bfhi(unsigned w) { return __uint_as_float(w & 0xffff0000u); }
__device__ __forceinline__ float swap1(float v) { return __int_as_float(__builtin_amdgcn_update_dpp(0, __float_as_int(v), 0xB1, 0xF, 0xF, false)); }
__device__ __forceinline__ float wave_sum(float v) {
#pragma unroll
    for (int o = 32; o > 0; o >>= 1) v += __shfl_xor(v, o);
    return v;
}
__device__ __forceinline__ void st_bf16_pair(bf16* p_even_aligned_base, int col, float v, int lane) {
    const float vn = swap1(v);
    if ((lane & 1) == 0) *(unsigned*)(p_even_aligned_base + col) = cvtpk(v, vn);
}

template <int BM_, int BN_, int WM_, int WN_> struct GC {
    static constexpr int BM = BM_, BN = BN_, WM = WM_, WN = WN_, TM = BM / WM, TN = BN / WN, MI = TM / 16, NJ = TN / 16;
    static constexpr int NA = BM / 64;
    static constexpr int NQ = BN / 4;
    static constexpr int KG = NTHR / NQ;
    static constexpr int KR = 64 / KG;
    static constexpr int A_BYTES = BM * 128, B_BYTES = BN * 128, STAGE = A_BYTES + B_BYTES;
    static_assert(WM * WN == 8 && (KR == 4 || KR == 8) && 2 * STAGE <= LDS_BYTES - 1024, "cfg");
};

template <class C, class AF, class BF, class EF>
__device__ __forceinline__ void gemm_tile(char* lds, const int nk, const AF& af, const BF& bf, const EF& ef) {
    const int tid = TID(), lane = tid & 63, wid = tid >> 6;
    const int wm = wid / C::WN, wn = wid % C::WN;
    const int ac = tid & 7, ar0 = tid >> 3;
    const bf16* aptr[C::NA];
#pragma unroll
    for (int i = 0; i < C::NA; ++i) aptr[i] = af.row(ar0 + 64 * i) + ac * 8;
    const int alds0 = ar0 * 128 + ((ac ^ ((ar0 >> 1) & 7)) << 4);
    const int n4 = tid % C::NQ, kg = tid / C::NQ;
    long ldb = 0; const float* bptr = bf.col(n4 * 4, ldb); const float* gk = bf.gk;
    int blds[4];
#pragma unroll
    for (int e = 0; e < 4; ++e) { const int n = n4 * 4 + e; const int sw = (n >> 1) & 7;
        blds[e] = C::A_BYTES + n * 128 + (C::KR == 8 ? ((kg ^ sw) << 4) : ((((kg >> 1) ^ sw) << 4) + (kg & 1) * 8)); }
    bf16x8 areg[C::NA]; f32x4 breg[C::KR]; float greg[C::KR];
    auto gload = [&](int kt) {
        const long ko = af.koff(kt * 64);
#pragma unroll
        for (int i = 0; i < C::NA; ++i) areg[i] = *reinterpret_cast<const bf16x8*>(aptr[i] + ko);
        if (bptr) {
#pragma unroll
            for (int kk = 0; kk < C::KR; ++kk) { breg[kk] = *reinterpret_cast<const f32x4*>(bptr + (long)(kt * 64 + kg * C::KR + kk) * ldb);
                if (gk) greg[kk] = gk[kt * 64 + kg * C::KR + kk]; }
        } else {
#pragma unroll
            for (int kk = 0; kk < C::KR; ++kk) breg[kk] = f32x4{0.f, 0.f, 0.f, 0.f};
        }
    };
    auto lstore = [&](char* buf) {
#pragma unroll
        for (int i = 0; i < C::NA; ++i) *reinterpret_cast<bf16x8*>(buf + alds0 + i * 64 * 128) = areg[i];
        if (gk && bptr) {
#pragma unroll
            for (int kk = 0; kk < C::KR; ++kk) breg[kk] = breg[kk] * greg[kk]; }
#pragma unroll
        for (int e = 0; e < 4; ++e) {
            if constexpr (C::KR == 8) {
                u32x4 w = {cvtpk(breg[0][e], breg[1][e]), cvtpk(breg[2][e], breg[3][e]), cvtpk(breg[4][e], breg[5][e]), cvtpk(breg[6][e], breg[7][e])};
                *reinterpret_cast<u32x4*>(buf + blds[e]) = w;
            } else {
                u32x2 w = {cvtpk(breg[0][e], breg[1][e]), cvtpk(breg[2][e], breg[3][e])};
                *reinterpret_cast<u32x2*>(buf + blds[e]) = w;
            }
        }
    };
    f32x4 acc[C::MI][C::NJ];
#pragma unroll
    for (int i = 0; i < C::MI; ++i)
#pragma unroll
        for (int j = 0; j < C::NJ; ++j) acc[i][j] = f32x4{0.f, 0.f, 0.f, 0.f};
    const int fsw = (lane >> 1) & 7, fq = lane >> 4;
    const int foff0 = (lane & 15) * 128 + (((0 + fq) ^ fsw) << 4), foff1 = (lane & 15) * 128 + (((4 + fq) ^ fsw) << 4);
    gload(0); lstore(lds); __syncthreads();
    for (int kt = 0; kt < nk; ++kt) {
        char* cur = lds + (kt & 1) * C::STAGE; char* nxt = lds + ((kt + 1) & 1) * C::STAGE;
        if (kt + 1 < nk) gload(kt + 1);
#pragma unroll
        for (int ks = 0; ks < 2; ++ks) {
            const int fo = ks ? foff1 : foff0;
            bf16x8 a[C::MI], b[C::NJ];
#pragma unroll
            for (int i = 0; i < C::MI; ++i) a[i] = *reinterpret_cast<const bf16x8*>(cur + (wm * C::TM + i * 16) * 128 + fo);
#pragma unroll
            for (int j = 0; j < C::NJ; ++j) b[j] = *reinterpret_cast<const bf16x8*>(cur + C::A_BYTES + (wn * C::TN + j * 16) * 128 + fo);
#pragma unroll
            for (int i = 0; i < C::MI; ++i)
#pragma unroll
                for (int j = 0; j < C::NJ; ++j) acc[i][j] = __builtin_amdgcn_mfma_f32_16x16x32_bf16(a[i], b[j], acc[i][j], 0, 0, 0);
        }
        if (kt + 1 < nk) lstore(nxt);
        __syncthreads();
    }
    ef.template run<C>(acc, wm, wn, lane);
}

__device__ __forceinline__ void row_inv_to_lds(char* lds, const float* hssq, const int m0) {
    const int tid = TID();
    if (tid < 128) { const float* q = hssq + (long)(m0 + tid) * 32; float ss = 0.f;
#pragma unroll
        for (int i = 0; i < 8; ++i) { const f32x4 v = *reinterpret_cast<const f32x4*>(q + i * 4); ss += (v[0] + v[1]) + (v[2] + v[3]); }
        ((float*)(lds + L_RINV))[tid] = rsqrtf(ss * (1.f / DM) + 1e-6f); }
}
struct ARowsPlain {
    const bf16* base; long lda; int m0, mmax;
    __device__ __forceinline__ const bf16* row(int r) const { int R = m0 + r; R = R < mmax ? R : mmax - 1; return base + (long)R * lda; }
    __device__ __forceinline__ long koff(int k0) const { return k0; }
};
struct ARowsCmp {
    const bf16* base; int m0;
    __device__ __forceinline__ const bf16* row(int r) const { int R = m0 + r; R = R < CMP_ROWS ? R : CMP_ROWS - 1;
        const int bg = R / NCMP, c = R - bg * NCMP, b = bg >> 1, g = bg & 1; return base + ((long)(b * S + c * 16) * 2 + g) * 128; }
    __device__ __forceinline__ long koff(int k0) const { return (long)(k0 >> 7) * 256 + (k0 & 127); }
};
struct ARowsGather {
    const bf16* base; const int* list; int r0, cnt;
    __device__ __forceinline__ const bf16* row(int r) const { int R = r0 + r; R = R < cnt ? R : cnt - 1; return base + (long)list[R] * DM; }
    __device__ __forceinline__ long koff(int k0) const { return k0; }
};
struct BPlain { const float* W; long ld; int n0, N; const float* gk;
    __device__ __forceinline__ const float* col(int c, long& ldo) const { ldo = ld; return (n0 + c < N) ? W + n0 + c : nullptr; } };
struct BRouter { const float* Wg; const float* We; const float* gk;
    __device__ __forceinline__ const float* col(int c, long& ldo) const {
        if (c < 8) { ldo = 8; return Wg + c; } if (c < 72) { ldo = 64; return We + (c - 8); } ldo = 8; return Wg; } };
struct BGateUp { const float* W1; const float* W3; int n0; const float* gk;
    __device__ __forceinline__ const float* col(int c, long& ldo) const { ldo = 512; const int wn = c >> 6, w = c & 63;
        const long d = (w & 32) ? (long)(W3 - W1) : 0L; return W1 + d + n0 + wn * 32 + (w & 31); } };

#define EPI_LOOP_BEGIN  _Pragma("unroll") for (int i = 0; i < C::MI; ++i) { _Pragma("unroll") for (int r = 0; r < 4; ++r) { \
        const int trow = wm * C::TM + i * 16 + (lane >> 4) * 4 + r; (void)trow;
#define EPI_LOOP_END }}

struct EpiF32 {
    float* Cc; const float* Rr; long ldc; int m0, n0, mmax;
    template <class C> __device__ __forceinline__ void run(f32x4 (&acc)[C::MI][C::NJ], int wm, int wn, int lane) const {
        EPI_LOOP_BEGIN
            const int R = m0 + trow;
            if (R < mmax) {
#pragma unroll
                for (int j = 0; j < C::NJ; ++j) { const long o = (long)R * ldc + n0 + wn * C::TN + j * 16 + (lane & 15);
                    float v = acc[i][j][r]; if (Rr) v += Rr[o]; Cc[o] = v; }
            }
        EPI_LOOP_END
    }
};
struct EpiBf16 {
    bf16* Cc; long ldc; int m0, n0, mmax; const float* rinv;
    template <class C> __device__ __forceinline__ void run(f32x4 (&acc)[C::MI][C::NJ], int wm, int wn, int lane) const {
        EPI_LOOP_BEGIN
            const int R = m0 + trow; const bool ok = R < mmax; const float ri = rinv ? rinv[trow] : 1.f;
#pragma unroll
            for (int j = 0; j < C::NJ; ++j) { const float v = acc[i][j][r] * ri; const float vn = swap1(v);
                if (ok && !(lane & 1)) *(unsigned*)(Cc + (long)R * ldc + n0 + wn * C::TN + j * 16 + (lane & 15)) = cvtpk(v, vn); }
        EPI_LOOP_END
    }
};
struct EpiQup {
    bf16* q; const float* cosA; const float* sinA; int m0, n0;
    template <class C> __device__ __forceinline__ void run(f32x4 (&acc)[C::MI][C::NJ], int wm, int wn, int lane) const {
        static_assert(C::TN == 64, "rope epilogue needs 64-col wave tiles");
        const int base = n0 + wn * 64, h = base / 192, db = base - h * 192;
        EPI_LOOP_BEGIN
            const int R = m0 + trow; bf16* qp = q + ((long)R * 8 + h) * 192 + db;
            if (db < 128) {
#pragma unroll
                for (int j = 0; j < 4; ++j) { const float v = acc[i][j][r]; const float vn = swap1(v);
                    if (!(lane & 1)) *(unsigned*)(qp + j * 16 + (lane & 15)) = cvtpk(v, vn); }
            } else {
#pragma unroll
                for (int j = 0; j < 2; ++j) { const int f = j * 16 + (lane & 15);
                    const float c = cosA[(long)R * 32 + f], s = sinA[(long)R * 32 + f];
                    const float x1 = acc[i][j][r], x2 = acc[i][j + 2][r];
                    const float o1 = x1 * c - x2 * s, o2 = x2 * c + x1 * s;
                    const float o1n = swap1(o1), o2n = swap1(o2);
                    if (!(lane & 1)) { *(unsigned*)(qp + f) = cvtpk(o1, o1n); *(unsigned*)(qp + 32 + f) = cvtpk(o2, o2n); } }
            }
        EPI_LOOP_END
    }
};
struct EpiKVup {
    bf16* k; bf16* v; int m0, n0;
    template <class C> __device__ __forceinline__ void run(f32x4 (&acc)[C::MI][C::NJ], int wm, int wn, int lane) const {
        static_assert(C::TN == 64, "64-col wave tiles");
        const int base = n0 + wn * 64, h = base >> 8, db = base & 255;
        EPI_LOOP_BEGIN
            const int R = m0 + trow;
            bf16* dp = (db < 128) ? k + ((long)R * 8 + h) * 192 + db : v + ((long)R * 8 + h) * 128 + (db - 128);
#pragma unroll
            for (int j = 0; j < 4; ++j) { const float x = acc[i][j][r]; const float xn = swap1(x);
                if (!(lane & 1)) *(unsigned*)(dp + j * 16 + (lane & 15)) = cvtpk(x, xn); }
        EPI_LOOP_END
    }
};
__device__ __forceinline__ float gelu_tanh(float x) {
    const float u = 0.7978845608028654f * (x + 0.044715f * x * x * x);
    const float e = __expf(2.f * u);
    const float t = 1.f - 2.f / (e + 1.f);
    return 0.5f * x * (1.f + t);
}
struct EpiCmp1 {
    bf16* hid; const float* bias; int m0, n0;
    template <class C> __device__ __forceinline__ void run(f32x4 (&acc)[C::MI][C::NJ], int wm, int wn, int lane) const {
        EPI_LOOP_BEGIN
            const int R = m0 + trow;
#pragma unroll
            for (int j = 0; j < C::NJ; ++j) { const int cg = n0 + wn * C::TN + j * 16 + (lane & 15);
                const float v = gelu_tanh(acc[i][j][r] + bias[cg]); const float vn = swap1(v);
                if (!(lane & 1)) *(unsigned*)(hid + (long)R * 512 + cg) = cvtpk(v, vn); }
        EPI_LOOP_END
    }
};
struct EpiCmp2 {
    bf16* outp; int m0;
    template <class C> __device__ __forceinline__ void run(f32x4 (&acc)[C::MI][C::NJ], int wm, int wn, int lane) const {
        EPI_LOOP_BEGIN
            const int R = m0 + trow; const bool ok = R < CMP_ROWS; const int bg = R / NCMP, c = R - bg * NCMP;
#pragma unroll
            for (int j = 0; j < C::NJ; ++j) { const float v = acc[i][j][r]; const float vn = swap1(v);
                if (ok && !(lane & 1)) *(unsigned*)(outp + ((long)bg * 128 + c) * 128 + wn * C::TN + j * 16 + (lane & 15)) = cvtpk(v, vn); }
        EPI_LOOP_END
    }
};
struct EpiMoe1 {
    bf16* hb; int n0, valid;
    template <class C> __device__ __forceinline__ void run(f32x4 (&acc)[C::MI][C::NJ], int wm, int wn, int lane) const {
        static_assert(C::TN == 64, "gate/up wave tile");
        EPI_LOOP_BEGIN
            const bool ok = trow < valid;
#pragma unroll
            for (int j = 0; j < 2; ++j) { const float g = acc[i][j][r], u = acc[i][j + 2][r];
                const float v = g / (1.f + __expf(-g)) * u; const float vn = swap1(v);
                if (ok && !(lane & 1)) *(unsigned*)(hb + (long)trow * 512 + n0 + wn * 32 + j * 16 + (lane & 15)) = cvtpk(v, vn); }
        EPI_LOOP_END
    }
};
struct EpiMoe2 {
    bf16* yb; const float* gate; int n0, valid;
    template <class C> __device__ __forceinline__ void run(f32x4 (&acc)[C::MI][C::NJ], int wm, int wn, int lane) const {
        EPI_LOOP_BEGIN
            const bool ok = trow < valid; const float gt = ok ? gate[trow] : 0.f;
#pragma unroll
            for (int j = 0; j < C::NJ; ++j) { const float v = acc[i][j][r] * gt; const float vn = swap1(v);
                if (ok && !(lane & 1)) *(unsigned*)(yb + (long)trow * DM + n0 + wn * C::TN + j * 16 + (lane & 15)) = cvtpk(v, vn); }
        EPI_LOOP_END
    }
};
struct EpiRouter {
    char* lds; const float* bg; const float* be; int* cnt; int* toke; int* tokr; int* elist; float* egate; float* einv; int m0;
    template <class C> __device__ __forceinline__ void run(f32x4 (&acc)[C::MI][C::NJ], int wm, int wn, int lane) const {
        float* lg = (float*)lds;
        EPI_LOOP_BEGIN
#pragma unroll
            for (int j = 0; j < C::NJ; ++j) { const int c = wn * C::TN + j * 16 + (lane & 15); if (c < 72) lg[trow * 73 + c] = acc[i][j][r] * ((const float*)(lds + L_RINV))[trow]; }
        EPI_LOOP_END
        __syncthreads();
        const int tid = TID();
        if (tid < 128) {
            const float* L = lg + tid * 73; const int t = m0 + tid;
            float gl[8]; float gm = -3e38f; int gi = 0;
#pragma unroll
            for (int g = 0; g < 8; ++g) { gl[g] = L[g] + bg[g]; if (gl[g] > gm) { gm = gl[g]; gi = g; } }
            float den = 0.f;
#pragma unroll
            for (int g = 0; g < 8; ++g) den += __expf(gl[g] - gm);
            const float ptop = 1.f / den;
            float v1 = -3e38f, v2 = -3e38f; int i1 = 0, i2 = 0;
#pragma unroll
            for (int e = 0; e < 8; ++e) { const float v = L[8 + gi * 8 + e] + be[gi * 8 + e];
                if (v > v1) { v2 = v1; i2 = i1; v1 = v; i1 = e; } else if (v > v2) { v2 = v; i2 = e; } }
            const float e2 = __expf(v2 - v1); const float w1 = 1.f / (1.f + e2), w2 = e2 / (1.f + e2);
            const int ex1 = gi * 8 + i1, ex2 = gi * 8 + i2;
            const int r1 = atomicAdd(&cnt[ex1], 1), r2 = atomicAdd(&cnt[ex2], 1);
            toke[t * 2] = ex1; toke[t * 2 + 1] = ex2; tokr[t * 2] = r1; tokr[t * 2 + 1] = r2;
            elist[ex1 * ECAP + r1] = t; elist[ex2 * ECAP + r2] = t;
            egate[ex1 * ECAP + r1] = ptop * w1; egate[ex2 * ECAP + r2] = ptop * w2;
            const float ri = ((const float*)(lds + L_RINV))[tid]; einv[ex1 * ECAP + r1] = ri; einv[ex2 * ECAP + r2] = ri;
        }
        __syncthreads();
    }
};
struct HEpiRouter {
    char* lds; const float* bg; const float* be; int* cnt; int* toke; int* tokr; int* elist; float* egate; float* einv; int m0;
    __device__ __forceinline__ void run(int, f32x4 (&acc)[2][4], int wm, int wn, int lane) const {
        float* lg = (float*)lds;
#pragma unroll
        for (int i = 0; i < 2; ++i)
#pragma unroll
            for (int r = 0; r < 4; ++r) { const int trow = wm * 32 + i * 16 + (lane >> 4) * 4 + r;
#pragma unroll
                for (int j = 0; j < 4; ++j) { const int c = wn * 64 + j * 16 + (lane & 15); if (c < 72) lg[trow * 73 + c] = acc[i][j][r] * ((const float*)(lds + L_RINV))[trow]; } }
        __syncthreads();
        const int tid = TID();
        if (tid < 128) {
            const float* L = lg + tid * 73; const int t = m0 + tid;
            float gl[8]; float gm = -3e38f; int gi = 0;
#pragma unroll
            for (int g = 0; g < 8; ++g) { gl[g] = L[g] + bg[g]; if (gl[g] > gm) { gm = gl[g]; gi = g; } }
            float den = 0.f;
#pragma unroll
            for (int g = 0; g < 8; ++g) den += __expf(gl[g] - gm);
            const float ptop = 1.f / den;
            float v1 = -3e38f, v2 = -3e38f; int i1 = 0, i2 = 0;
#pragma unroll
            for (int e = 0; e < 8; ++e) { const float v = L[8 + gi * 8 + e] + be[gi * 8 + e];
                if (v > v1) { v2 = v1; i2 = i1; v1 = v; i1 = e; } else if (v > v2) { v2 = v; i2 = e; } }
            const float e2 = __expf(v2 - v1); const float w1 = 1.f / (1.f + e2), w2 = e2 / (1.f + e2);
            const int ex1 = gi * 8 + i1, ex2 = gi * 8 + i2;
            const int r1 = atomicAdd(&cnt[ex1], 1), r2 = atomicAdd(&cnt[ex2], 1);
            toke[t * 2] = ex1; toke[t * 2 + 1] = ex2; tokr[t * 2] = r1; tokr[t * 2 + 1] = r2;
            elist[ex1 * ECAP + r1] = t; elist[ex2 * ECAP + r2] = t;
            egate[ex1 * ECAP + r1] = ptop * w1; egate[ex2 * ECAP + r2] = ptop * w2;
            const float ri = ((const float*)(lds + L_RINV))[tid]; einv[ex1 * ECAP + r1] = ri; einv[ex2 * ECAP + r2] = ri;
        }
        __syncthreads();
    }
};

constexpr float ATT_THR = 8.f;
__device__ __forceinline__ int v_st(int k, int c) { const int kk = (k & ~0xC) | ((k & 4) << 1) | ((k & 8) >> 1); return ((kk >> 3) * 4 + (c >> 5)) * 512 + ((kk & 7) * 32 + (c & 31)) * 2; }
__device__ __forceinline__ int v_rd_base(int lane) { return ((lane & 3) << 3) | (((lane >> 2) & 3) << 6) | (((lane >> 4) & 1) << 5) | (((lane >> 5) & 1) << 8); }
constexpr int v_rd_off(int d0, int ks, int half) { return d0 * 512 + ks * 4096 + half * 2048; }
__device__ __forceinline__ int crow(int r, int hi) { return (r & 3) + 8 * (r >> 2) + 4 * hi; }

__device__ __forceinline__ void mask_tile(f32x16& p0, f32x16& p1, int dq, unsigned W) {
    const float NEG = -__builtin_inff();
#pragma unroll
    for (int r = 0; r < 16; ++r) {
        const int c = (r & 3) + 8 * (r >> 2);
        if ((unsigned)(dq - c) >= W) p0[r] = NEG;
        if ((unsigned)(dq - c - 32) >= W) p1[r] = NEG;
    }
}
__device__ __forceinline__ void mask_all(f32x16& p0, f32x16& p1, bool keep) {
    const float NEG = -__builtin_inff();
#pragma unroll
    for (int r = 0; r < 16; ++r) { p0[r] = keep ? p0[r] : NEG; p1[r] = keep ? p1[r] : NEG; }
}
__device__ __forceinline__ void partialSM(f32x16& p0, f32x16& p1, float& m_reg, float& mn, float& alpha, const float C2, const float scl) {
    float pmax = p0[0];
#pragma unroll
    for (int r = 1; r < 16; ++r) pmax = fmaxf(pmax, p0[r]);
#pragma unroll
    for (int r = 0; r < 16; ++r) pmax = fmaxf(pmax, p1[r]);
    { auto rr = __builtin_amdgcn_permlane32_swap(__float_as_uint(pmax), __float_as_uint(pmax), false, false);
      pmax = fmaxf(__uint_as_float(rr[0]), __uint_as_float(rr[1])); }
    if (__builtin_expect(__all((pmax - m_reg) * scl <= ATT_THR), 1)) { mn = m_reg; alpha = 1.f; }
    else { mn = fmaxf(m_reg, pmax); alpha = __builtin_amdgcn_exp2f((m_reg - mn) * C2); m_reg = mn; }
    const float mnL = -mn * C2;
#pragma unroll
    for (int r = 0; r < 16; ++r) p0[r] = fmaf(p0[r], C2, mnL);
#pragma unroll
    for (int r = 0; r < 16; ++r) p1[r] = fmaf(p1[r], C2, mnL);
#pragma unroll
    for (int r = 0; r < 16; ++r) p0[r] = __builtin_amdgcn_exp2f(p0[r]);
}
__device__ __forceinline__ void finishSM(f32x16& p0, f32x16& p1, float alpha, float& l_reg, bf16x8& pa0, bf16x8& pa1, bf16x8& pa2, bf16x8& pa3) {
#pragma unroll
    for (int r = 0; r < 16; ++r) p1[r] = __builtin_amdgcn_exp2f(p1[r]);
    float ps = 0;
#pragma unroll
    for (int r = 0; r < 16; ++r) ps += p0[r];
#pragma unroll
    for (int r = 0; r < 16; ++r) ps += p1[r];
    { auto rr = __builtin_amdgcn_permlane32_swap(__float_as_uint(ps), __float_as_uint(ps), false, false);
      ps = __uint_as_float(rr[0]) + __uint_as_float(rr[1]); }
    l_reg = l_reg * alpha + ps;
#define PK4(P, B_, OUT) do { unsigned a0 = cvtpk(P[B_+0], P[B_+1]), a1 = cvtpk(P[B_+2], P[B_+3]);                          \
        unsigned b0 = cvtpk(P[B_+4], P[B_+5]), b1 = cvtpk(P[B_+6], P[B_+7]);                                             \
        auto r0 = __builtin_amdgcn_permlane32_swap(a0, b0, false, false); auto r1 = __builtin_amdgcn_permlane32_swap(a1, b1, false, false); \
        u32x4 w = {r0[0], r1[0], r0[1], r1[1]}; OUT = *reinterpret_cast<bf16x8*>(&w); } while (0)
    PK4(p0, 0, pa0); PK4(p0, 8, pa1); PK4(p1, 0, pa2); PK4(p1, 8, pa3);
#undef PK4
}
#define KSWZ(row, colB, RB) ((row) * (RB) + ((colB) ^ (((row) & 7) << 4)))
template <int DQK, int KB>
__device__ __forceinline__ void qkt(f32x16& p0, f32x16& p1, const char* K_lds, int r32, int hi, const bf16x8* qr) {
    constexpr int RB = DQK * 2, SHMK = 64 * RB;
    p0 = f32x16{}; p1 = f32x16{};
    const char* kb[4];
#pragma unroll
    for (int dd = 0; dd < 4; ++dd) kb[dd] = K_lds + KB * SHMK + KSWZ(r32, (dd * 16 + hi * 8) * 2, RB);
#pragma unroll
    for (int d0 = 0; d0 < DQK / 16; ++d0) { const char* a = kb[d0 & 3] + (d0 >> 2) * 128;
        bf16x8 b0 = *reinterpret_cast<const bf16x8*>(a);
        bf16x8 b1 = *reinterpret_cast<const bf16x8*>(a + 32 * RB);
        p0 = __builtin_amdgcn_mfma_f32_32x32x16_bf16(b0, qr[d0], p0, 0, 0, 0);
        p1 = __builtin_amdgcn_mfma_f32_32x32x16_bf16(b1, qr[d0], p1, 0, 0, 0); }
}
#define TRRD(dst, off) asm volatile("ds_read_b64_tr_b16 %0, %1 offset:%2" : "=&v"(dst) : "v"(vbx_), "i"(off) : "memory")
#define PV_BLK(ACC, VBX, b_, s0, s1) do { s16x4 l0, l1, l2, l3, h0, h1, h2, h3; const int vbx_ = (VBX);                                                 \
        TRRD(l0, (b_)); TRRD(h0, (b_) + (s0)); TRRD(l1, (b_) + (s1)); TRRD(h1, (b_) + (s1) + (s0)); TRRD(l2, (b_) + 2 * (s1)); TRRD(h2, (b_) + 2 * (s1) + (s0)); \
        TRRD(l3, (b_) + 3 * (s1)); TRRD(h3, (b_) + 3 * (s1) + (s0));                                                           \
        asm volatile("s_waitcnt lgkmcnt(0)" ::: "memory"); SBAR();                                                           \
        ACC = __builtin_amdgcn_mfma_f32_32x32x16_bf16(pa0, (bf16x8){l0[0], l0[1], l0[2], l0[3], h0[0], h0[1], h0[2], h0[3]}, ACC, 0, 0, 0);   \
        ACC = __builtin_amdgcn_mfma_f32_32x32x16_bf16(pa1, (bf16x8){l1[0], l1[1], l1[2], l1[3], h1[0], h1[1], h1[2], h1[3]}, ACC, 0, 0, 0);   \
        ACC = __builtin_amdgcn_mfma_f32_32x32x16_bf16(pa2, (bf16x8){l2[0], l2[1], l2[2], l2[3], h2[0], h2[1], h2[2], h2[3]}, ACC, 0, 0, 0);   \
        ACC = __builtin_amdgcn_mfma_f32_32x32x16_bf16(pa3, (bf16x8){l3[0], l3[1], l3[2], l3[3], h3[0], h3[1], h3[2], h3[3]}, ACC, 0, 0, 0); } while (0)
template <int VB, int PVM>
__device__ __forceinline__ void pv_tile(f32x16* o, int vb0, bf16x8 pa0, bf16x8 pa1, bf16x8 pa2, bf16x8 pa3) {
    if constexpr (PVM == 0 || PVM == 2) {
        PV_BLK(o[0], vb0, VB * SHM_V + 0 * 512, 2048, 4096);
        PV_BLK(o[1], vb0, VB * SHM_V + 1 * 512, 2048, 4096);
        PV_BLK(o[2], vb0, VB * SHM_V + 2 * 512, 2048, 4096);
        PV_BLK(o[3], vb0, VB * SHM_V + 3 * 512, 2048, 4096);
    }
    if constexpr (PVM == 1) { PV_BLK(o[0], vb0 + L_OV, VB * 4096, 512, 1024); }
    if constexpr (PVM == 2) { PV_BLK(o[4], vb0 + L_OV, VB * 4096, 512, 1024); }
}

template <int DQK, int MODE, int PVM, int PIPE = ATT_PIPE2>
__device__ __forceinline__ void flash_pass(const int tid, char* lds, const bf16x8* qr, const bf16* __restrict__ Kg, const long ldk,
                                           const bf16* __restrict__ Vg, const long ldv, const int NT, const int j_lo,
                                           const int epos, const int qlo_e, const unsigned W, const unsigned selm,
                                           const float C2, const float scl, f32x16* o, float& l_out) {
    constexpr int RB = DQK * 2, SHMK = 64 * RB;
    const int wid = __builtin_amdgcn_readfirstlane(tid >> 6), lane = tid & 63, r32 = lane & 31, hi = lane >> 5;
    char* V_lds = lds + L_V; char* K_lds = lds + L_K;
    float* wsp = (float*)(lds + L_WS) + wid * 128; float* al_l = wsp + 32;
    const volatile int* tl = (const volatile int*)(lds + L_TL);
    float m_reg = -1e30f, l_reg = 0.f;
#pragma unroll
    for (int d = 0; d < (PVM == 1 ? 1 : (PVM == 2 ? 5 : 4)); ++d) o[d] = f32x16{};
    const int sr = tid >> 4, sc = (tid & 15) * 8, vst0 = v_st(sr, sc), vst1 = v_st(32 + sr, sc), kws = KSWZ(sr, sc * 2, RB);
    const int sr3 = tid >> 3, sc3 = 128 + (tid & 7) * 8, kws3 = KSWZ(sr3, sc3 * 2, RB);
    const int vb0 = (int)(uintptr_t)V_lds + v_rd_base(lane);
    const int qm = epos - 4 * hi;
    bf16x8 st_v0, st_v1, st_k0, st_k1, st_k2;
#define KT(t) (MODE == 2 ? __builtin_amdgcn_readfirstlane(tl[(t)]) : (j_lo + (t)))
#define VMW() asm volatile("s_waitcnt vmcnt(0)" ::: "memory")
#define SLOAD(t) do { const long k0_ = (long)KT(t) * 64;                                                                        \
        if constexpr (PVM != 1) { st_v0 = *reinterpret_cast<const bf16x8*>(Vg + (k0_ + sr) * ldv + sc); st_v1 = *reinterpret_cast<const bf16x8*>(Vg + (k0_ + 32 + sr) * ldv + sc); } \
        st_k0 = *reinterpret_cast<const bf16x8*>(Kg + (k0_ + sr) * ldk + sc); st_k1 = *reinterpret_cast<const bf16x8*>(Kg + (k0_ + 32 + sr) * ldk + sc); \
        if constexpr (DQK == 192) st_k2 = *reinterpret_cast<const bf16x8*>(Kg + (k0_ + sr3) * ldk + sc3); } while (0)
#define SWRITE(bf) do { if constexpr (PVM != 1) { *(bf16x8*)(V_lds + (bf) * SHM_V + vst0) = st_v0; *(bf16x8*)(V_lds + (bf) * SHM_V + vst1) = st_v1; }    \
        *(bf16x8*)(K_lds + (bf) * SHMK + kws) = st_k0; *(bf16x8*)(K_lds + (bf) * SHMK + kws + 32 * RB) = st_k1;               \
        if constexpr (DQK == 192) *(bf16x8*)(K_lds + (bf) * SHMK + kws3) = st_k2; } while (0)
#define RESC(a) do { if (__any((a) < 1.f)) { if (hi == 0) al_l[r32] = (a); asm volatile("s_waitcnt lgkmcnt(0)" ::: "memory");    \
        _Pragma("unroll") for (int d_ = 0; d_ < (PVM == 1 ? 1 : (PVM == 2 ? 5 : 4)); ++d_) { _Pragma("unroll") for (int r = 0; r < 16; ++r) o[d_][r] *= al_l[crow(r, hi)]; } } } while (0)
#define MASKT(P0_, P1_, t) do { if (MODE != 0) { const int kt_ = KT(t); const int kb_ = kt_ * 64;                               \
        if (MODE == 1) { if (kb_ + 63 > qlo_e || kb_ <= qlo_e + 31 - (int)W) mask_tile(P0_, P1_, qm - kb_, W); }             \
        else { if (kb_ + 63 > qlo_e) mask_tile(P0_, P1_, qm - kb_, 0x40000000u); mask_all(P0_, P1_, ((selm >> kt_) & 1u) != 0u); } } } while (0)
    if constexpr (PIPE == 2) {
    f32x16 pA0, pA1, pB0, pB1; float mnA, mnB, alA, alB; bf16x8 pa0, pa1, pa2, pa3;
    __syncthreads();
    SLOAD(0); VMW(); SWRITE(0);
    if (NT > 1) SLOAD(1);
    __syncthreads();
    SBAR(); qkt<DQK, 0>(pA0, pA1, K_lds, r32, hi, qr);
    MASKT(pA0, pA1, 0); partialSM(pA0, pA1, m_reg, mnA, alA, C2, scl);
    if (NT > 1) { VMW(); SWRITE(1); }
    __syncthreads();
#define HALF_STEP(PX0, PX1, mnX, alX, PY0, PY1, alY, t, KB, VB, SB) do {                                                      \
        SBAR(); qkt<DQK, KB>(PX0, PX1, K_lds, r32, hi, qr);                                                                   \
        finishSM(PY0, PY1, alY, l_reg, pa0, pa1, pa2, pa3); SBAR();                                                           \
        if ((t) + 1 < NT) { SLOAD((t) + 1); SBAR(); }                                                                         \
        pv_tile<VB, PVM>(o, vb0, pa0, pa1, pa2, pa3); MASKT(PX0, PX1, (t)); partialSM(PX0, PX1, m_reg, mnX, alX, C2, scl);    \
        __syncthreads();                                                                                                      \
        if ((t) + 1 < NT) { VMW(); SWRITE(SB); }                                                                              \
        RESC(alX); __syncthreads(); } while (0)
    for (int t = 1; t + 1 < NT; t += 2) {
        HALF_STEP(pB0, pB1, mnB, alB, pA0, pA1, alA, t, 1, 0, 0);
        HALF_STEP(pA0, pA1, mnA, alA, pB0, pB1, alB, t + 1, 0, 1, 1);
    }
    const bool even = (NT & 1) == 0;
    if (even) { SBAR(); qkt<DQK, 1>(pB0, pB1, K_lds, r32, hi, qr); SBAR(); }
    finishSM(pA0, pA1, alA, l_reg, pa0, pa1, pa2, pa3); SBAR();
    pv_tile<0, PVM>(o, vb0, pa0, pa1, pa2, pa3);
    if (even) { MASKT(pB0, pB1, NT - 1); partialSM(pB0, pB1, m_reg, mnB, alB, C2, scl); __syncthreads(); RESC(alB);
        finishSM(pB0, pB1, alB, l_reg, pa0, pa1, pa2, pa3); SBAR(); pv_tile<1, PVM>(o, vb0, pa0, pa1, pa2, pa3); }
#undef HALF_STEP
    } else {
    f32x16 p0, p1; float mn, al; bf16x8 pa0, pa1, pa2, pa3;
    constexpr int NKI = SHMK / 8192;
    unsigned kof[NKI], vof[2];
#pragma unroll
    for (int i = 0; i < NKI; ++i) { const int x = (wid * NKI + i) * 1024 + lane * 16, row = x / RB, pc = x - row * RB; kof[i] = (unsigned)(row * (int)ldk + ((pc ^ ((row & 7) << 4)) >> 1)) * 2u; }
#pragma unroll
    for (int i = 0; i < 2; ++i) { const int x = (wid * 2 + i) * 1024 + lane * 16, stl = x >> 9, y = x & 511, kk = (stl >> 2) * 8 + (y >> 6);
        const int k = (kk & ~0xC) | ((kk & 4) << 1) | ((kk & 8) >> 1), c = (stl & 3) * 32 + ((y & 63) >> 1); vof[i] = (unsigned)(k * (int)ldv + c) * 2u; }
#define DMA_TILE(bf, t) do { const long k0_ = (long)KT(t) * 64;                                                                  \
        _Pragma("unroll") for (int i = 0; i < NKI; ++i) __builtin_amdgcn_global_load_lds((const unsigned*)((const char*)(Kg + k0_ * ldk) + kof[i]),      \
            (LAS unsigned*)((LAS char*)K_lds + (bf) * SHMK + (wid * NKI + i) * 1024), 16, 0, 0);                                 \
        if constexpr (PVM != 1) { _Pragma("unroll") for (int i = 0; i < 2; ++i) __builtin_amdgcn_global_load_lds((const unsigned*)((const char*)(Vg + k0_ * ldv) + vof[i]), \
            (LAS unsigned*)((LAS char*)V_lds + (bf) * SHM_V + (wid * 2 + i) * 1024), 16, 0, 0); } } while (0)
    __syncthreads();
    DMA_TILE(0, 0);
    __syncthreads();
#define STEP(t, KB) do {                                                                                                       \
        if ((t) + 1 < NT) DMA_TILE(1 - KB, (t) + 1);                                                                           \
        SBAR(); qkt<DQK, KB>(p0, p1, K_lds, r32, hi, qr);                                                                      \
        MASKT(p0, p1, (t)); partialSM(p0, p1, m_reg, mn, al, C2, scl); RESC(al);                                               \
        finishSM(p0, p1, al, l_reg, pa0, pa1, pa2, pa3); SBAR();                                                               \
        pv_tile<KB, PVM>(o, vb0, pa0, pa1, pa2, pa3);                                                                          \
        asm volatile("s_waitcnt vmcnt(0)" ::: "memory"); __syncthreads(); } while (0)
    int t = 0;
    for (; t + 1 < NT; t += 2) { STEP(t, 0); STEP(t + 1, 1); }
    if (t < NT) STEP(t, 0);
#undef DMA_TILE
#undef STEP
    }
    l_out = l_reg;
#undef KT
#undef VMW
#undef SLOAD
#undef SWRITE
#undef RESC
#undef MASKT
}

#define WS_PTR(T_, off) ((T_*)(p.ws + (off)))
#define ROW_SCALES(sc, lval, gval, USE_G) do { if (hi == 0) { wsp[r32] = (lval); if (USE_G) wsp[64 + r32] = (gval); }                \
        asm volatile("s_waitcnt lgkmcnt(0)" ::: "memory");                                                                        \
        _Pragma("unroll") for (int r = 0; r < 16; ++r) { const float li_ = wsp[crow(r, hi)]; float s_ = li_ > 0.f ? __builtin_amdgcn_rcpf(li_) : 0.f; \
            if (USE_G) s_ *= wsp[64 + crow(r, hi)]; sc[r] = s_; } } while (0)

__device__ __forceinline__ void mla_unit(const Params& p, char* lds, const int b, const int h, const int qb) {
    const int tid = TID(), wid = __builtin_amdgcn_readfirstlane(tid >> 6), lane = tid & 63, r32 = lane & 31, hi = lane >> 5;
    const int t0 = qb * 256, tokw = t0 + wid * 32, tok = tokw + r32;
    const bf16* qp = WS_PTR(const bf16, WS_QMLA) + ((long)(b * S + tok) * 8 + h) * 192 + hi * 8;
    bf16x8 qr[12];
#pragma unroll
    for (int d0 = 0; d0 < 12; ++d0) qr[d0] = *reinterpret_cast<const bf16x8*>(qp + d0 * 16);
    {
        const float* cA = WS_PTR(const float, WS_COSA) + (long)(b * S + tok) * 32 + hi * 8; const float* sA = WS_PTR(const float, WS_SINA) + (long)(b * S + tok) * 32 + hi * 8;
#pragma unroll
        for (int dd = 0; dd < 2; ++dd) {
            const f32x4 c0 = *reinterpret_cast<const f32x4*>(cA + dd * 16), c1 = *reinterpret_cast<const f32x4*>(cA + dd * 16 + 4);
            const f32x4 s0 = *reinterpret_cast<const f32x4*>(sA + dd * 16), s1 = *reinterpret_cast<const f32x4*>(sA + dd * 16 + 4);
            const u32x4 a = *reinterpret_cast<const u32x4*>(&qr[8 + dd]), bq = *reinterpret_cast<const u32x4*>(&qr[10 + dd]);
            u32x4 oa, ob;
#pragma unroll
            for (int e = 0; e < 4; ++e) { const float x1l = bflo(a[e]), x1h = bfhi(a[e]), x2l = bflo(bq[e]), x2h = bfhi(bq[e]);
                const float cl = e < 2 ? c0[2 * e] : c1[2 * e - 4], ch = e < 2 ? c0[2 * e + 1] : c1[2 * e - 3];
                const float sl = e < 2 ? s0[2 * e] : s1[2 * e - 4], sh = e < 2 ? s0[2 * e + 1] : s1[2 * e - 3];
                oa[e] = cvtpk(x1l * cl - x2l * sl, x1h * ch - x2h * sh); ob[e] = cvtpk(x2l * cl + x1l * sl, x2h * ch + x1h * sh); }
            qr[8 + dd] = *reinterpret_cast<const bf16x8*>(&oa); qr[10 + dd] = *reinterpret_cast<const bf16x8*>(&ob);
        }
    }
    f32x16 o[4]; float l;
    const float scl = 0.07216878364870323f;
    flash_pass<192, 1, 0>(tid, lds, qr, WS_PTR(const bf16, WS_KMLA) + ((long)b * S * 8 + h) * 192, 8 * 192,
                              WS_PTR(const bf16, WS_VMLA) + ((long)b * S * 8 + h) * 128, 8 * 128, t0 / 64 + 4, 0, tok, tokw, 0x40000000u, 0u,
                              scl * 1.4426950408889634f, scl, o, l);
    float* wsp = (float*)(lds + L_WS) + wid * 128; float sc[16];
    ROW_SCALES(sc, l, 0.f, false);
    bf16* yo = WS_PTR(bf16, WS_Y) + (long)(b * S + tokw) * 2048 + h * 128;
    float* ys = WS_PTR(float, WS_YSSQ) + (long)(b * S + tokw) * 16 + h;
#pragma unroll
    for (int r = 0; r < 16; ++r) { const int row = crow(r, hi); float ss = 0.f;
#pragma unroll
        for (int d0 = 0; d0 < 4; ++d0) { const float v = o[d0][r] * sc[r]; const float vn = swap1(v); ss += v * v;
            if (!(lane & 1)) *(unsigned*)(yo + (long)row * 2048 + d0 * 32 + r32) = cvtpk(v, vn); }
        ss += swap1(ss); ss += __shfl_xor(ss, 2); ss += __shfl_xor(ss, 4); ss += __shfl_xor(ss, 8); ss += __shfl_xor(ss, 16);
        if (r32 == 0) ys[(long)row * 16] = ss; }
}

__device__ __forceinline__ void xattn_unit(const Params& p, char* lds, const int l, const int b, const int h, const int qb) {
    const int tid = TID(), wid = __builtin_amdgcn_readfirstlane(tid >> 6), lane = tid & 63, r32 = lane & 31, hi = lane >> 5;
    const int t0 = qb * 256, tokw = t0 + wid * 32, tok = tokw + r32;
    const bf16* qp = WS_PTR(const bf16, WS_QX) + ((long)(b * S + tok) * 4 + h) * 128 + hi * 8;
    bf16x8 qr[8];
#pragma unroll
    for (int d0 = 0; d0 < 8; ++d0) qr[d0] = *reinterpret_cast<const bf16x8*>(qp + d0 * 16);
    f32x16 o[4]; float lsum;
    const float scl = 0.08838834764831845f;
    const bf16* kv = WS_PTR(const bf16, WS_KVX) + (long)l * 1024 * 1024 + (long)b * 256 * 1024 + h * 128;
    flash_pass<128, 0, 0>(tid, lds, qr, kv, 1024, kv + 512, 1024, 4, 0, 0, 0, 0u, 0u, scl * 1.4426950408889634f, scl, o, lsum);
    float* wsp = (float*)(lds + L_WS) + wid * 128; float sc[16];
    ROW_SCALES(sc, lsum, 0.f, false);
    bf16* yo = WS_PTR(bf16, WS_OX) + (long)(b * S + tokw) * 512 + h * 128;
#pragma unroll
    for (int r = 0; r < 16; ++r) { const int row = crow(r, hi);
#pragma unroll
        for (int d0 = 0; d0 < 4; ++d0) { const float v = o[d0][r] * sc[r]; const float vn = swap1(v);
            if (!(lane & 1)) *(unsigned*)(yo + (long)row * 512 + d0 * 32 + r32) = cvtpk(v, vn); } }
}

#define NSA_CTX() const int tid = TID(), wid = __builtin_amdgcn_readfirstlane(tid >> 6), lane = tid & 63, r32 = lane & 31, hi = lane >> 5;             \
    const int hh = wid & 3, tsub = wid >> 2, head = g * 4 + hh; const int t0 = tb * 64, tokw = t0 + tsub * 32, tok = tokw + r32;                      \
    const bf16* qp = WS_PTR(const bf16, WS_QN) + ((long)(b * S + tok) * 8 + head) * 128 + hi * 8;                                                     \
    const float* gp = WS_PTR(const float, WS_GATES) + (long)(b * S + tok) * 24 + head * 3;                                                            \
    float* wsp = (float*)(lds + L_WS) + wid * 128; float* yo = WS_PTR(float, WS_YNSA) + (long)(b * S + tokw) * 1024 + head * 128;                      \
    const float scl = 0.08838834764831845f, C2 = scl * 1.4426950408889634f; (void)t0; (void)gp; (void)wsp; (void)yo; (void)tid;                        \
    bf16x8 qr[8]; _Pragma("unroll") for (int d0 = 0; d0 < 8; ++d0) qr[d0] = *reinterpret_cast<const bf16x8*>(qp + d0 * 16)
__device__ __forceinline__ void nsa_unit(const Params& p, char* lds, const int b, const int g, const int tb) {
    const bf16* kv6 = WS_PTR(const bf16, WS_KV6);
    const bf16* kcp = WS_PTR(const bf16, WS_KCMP) + (long)(b * 2 + g) * 128 * 128;
    {
        NSA_CTX();
        const int nvis = tok >= 31 ? ((tok - 31) >> 4) + 1 : 0;
        f32x16 o[5]; float lsum;
        flash_pass<128, 1, 2, 1>(tid, lds, qr, kcp, 128, kcp + 8 * 128 * 128, 128, 2, 0, nvis - 1, -(1 << 20), 0x40000000u, 0u, C2, scl, o, lsum);
        float sc[16];
        ROW_SCALES(sc, lsum, 0.f, false);
        float* imp = (float*)(lds + L_IMP) + wid * (32 * 33);
#pragma unroll
        for (int r = 0; r < 16; ++r) imp[crow(r, hi) * 33 + r32] = o[4][r] * sc[r];
        if (tid == 0) ((volatile unsigned*)(lds + L_MISC))[1] = 0u;
        const float g_c = gp[0];
        { if (hi == 0) wsp[64 + r32] = g_c; asm volatile("s_waitcnt lgkmcnt(0)" ::: "memory");
#pragma unroll
          for (int r = 0; r < 16; ++r) sc[r] *= wsp[64 + crow(r, hi)]; }
#pragma unroll
        for (int r = 0; r < 16; ++r) { const int row = crow(r, hi);
#pragma unroll
            for (int d0 = 0; d0 < 4; ++d0) yo[(long)row * 1024 + d0 * 32 + r32] = o[d0][r] * sc[r]; }
    }
    __syncthreads();
    {
        const int tid = TID();
        if (tid < 64) {
            const int ts = tid >> 5, rr = tid & 31; const float* ib = (const float*)(lds + L_IMP) + (ts * 4) * (32 * 33) + rr * 33;
            float v[32];
#pragma unroll
            for (int n = 0; n < 32; ++n) v[n] = ib[n] + ib[32 * 33 + n] + ib[2 * 32 * 33 + n] + ib[3 * 32 * 33 + n];
            const int cur = tb;
#pragma unroll
            for (int n = 0; n < 32; ++n) { const bool forced = (n == 0) || (n == cur); const bool vis = n <= cur; v[n] = forced ? 1e4f : (vis ? v[n] : -1e4f); }
            unsigned m = 0u;
#pragma unroll
            for (int k = 0; k < 8; ++k) { float best = -3.0e38f; int bi = 0;
#pragma unroll
                for (int n = 0; n < 32; ++n) { if (v[n] > best) { best = v[n]; bi = n; } }
                m |= 1u << bi;
#pragma unroll
                for (int n = 0; n < 32; ++n) v[n] = (n == bi) ? -3.3e38f : v[n]; }
            ((volatile unsigned*)(lds + L_SELM))[tid] = m;
            atomicOr((unsigned*)(lds + L_MISC) + 1, m);
        }
        __syncthreads();
        if (tid == 0) { volatile unsigned* misc = (volatile unsigned*)(lds + L_MISC); unsigned um = misc[1] & ((2u << tb) - 1u); int n = 0; volatile int* tl = (volatile int*)(lds + L_TL);
            while (um) { tl[n++] = __builtin_ctz(um); um &= um - 1u; } misc[2] = (unsigned)n; }
        __syncthreads();
    }
    {
        NSA_CTX();
        const unsigned selm = ((volatile unsigned*)(lds + L_SELM))[tsub * 32 + r32];
        const int ntl = __builtin_amdgcn_readfirstlane((int)((volatile unsigned*)(lds + L_MISC))[2]);
        f32x16 o[4]; float lsum;
        const bf16* kb = kv6 + 2 * KV6_STRIDE + ((long)b * S * 2 + g) * 128;
        flash_pass<128, 2, 0>(tid, lds, qr, kb, 256, kb + KV6_STRIDE, 256, ntl, 0, tok, tokw, 0x40000000u, selm, C2, scl, o, lsum);
        float sc[16]; const float g_s = gp[1];
        ROW_SCALES(sc, lsum, g_s, true);
#pragma unroll
        for (int r = 0; r < 16; ++r) { const int row = crow(r, hi);
#pragma unroll
            for (int d0 = 0; d0 < 4; ++d0) { float* a = yo + (long)row * 1024 + d0 * 32 + r32; *a = *a + o[d0][r] * sc[r]; } }
    }
    {
        NSA_CTX();
        f32x16 o[4]; float lsum;
        const bf16* kb = kv6 + 4 * KV6_STRIDE + ((long)b * S * 2 + g) * 128;
        const int jlo = tb > 8 ? tb - 8 : 0;
        flash_pass<128, 1, 0, 1>(tid, lds, qr, kb, 256, kb + KV6_STRIDE, 256, tb - jlo + 1, jlo, tok, tokw, 512u, 0u, C2, scl, o, lsum);
        float sc[16]; const float g_w = gp[2];
        ROW_SCALES(sc, lsum, g_w, true);
        bf16* yb = WS_PTR(bf16, WS_Y) + (long)(b * S + tokw) * 2048 + 1024 + head * 128;
        float* ys = WS_PTR(float, WS_YSSQ) + (long)(b * S + tokw) * 16 + 8 + head;
#pragma unroll
        for (int r = 0; r < 16; ++r) { const int row = crow(r, hi); float ss = 0.f;
#pragma unroll
            for (int d0 = 0; d0 < 4; ++d0) { const float v = yo[(long)row * 1024 + d0 * 32 + r32] + o[d0][r] * sc[r]; const float vn = swap1(v); ss += v * v;
                if (!(lane & 1)) *(unsigned*)(yb + (long)row * 2048 + d0 * 32 + r32) = cvtpk(v, vn); }
            ss += swap1(ss); ss += __shfl_xor(ss, 2); ss += __shfl_xor(ss, 4); ss += __shfl_xor(ss, 8); ss += __shfl_xor(ss, 16);
            if (r32 == 0) ys[(long)row * 16] = ss; }
    }
}
#undef NSA_CTX

__device__ __forceinline__ u32x2 pack4(f32x4 v) { return u32x2{cvtpk(v[0], v[1]), cvtpk(v[2], v[3])}; }
__device__ __forceinline__ f32x4 unpack4(u32x2 w) { return f32x4{bflo(w[0]), bfhi(w[0]), bflo(w[1]), bfhi(w[1])}; }

template <bool MOE>
__device__ __forceinline__ void norm_rows(const Params& p, const float* __restrict__ src, const int nrows, const float* __restrict__ gain,
                                          bf16* dbf, float* df32, float* hout, const int* offs) {
    const int tid = TID(), wid = tid >> 6, lane = tid & 63;
    f32x4 gv[8];
#pragma unroll
    for (int i = 0; i < 8; ++i) gv[i] = *reinterpret_cast<const f32x4*>(gain + (lane + 64 * i) * 4);
    int2 ne = {0, 0}, nr = {0, 0};
    if constexpr (MOE) { const int r0 = blockIdx.x * 8 + wid; if (r0 < nrows) { ne = *reinterpret_cast<const int2*>(WS_PTR(const int, WS_TOKE) + r0 * 2); nr = *reinterpret_cast<const int2*>(WS_PTR(const int, WS_TOKR) + r0 * 2); } }
    for (int row = blockIdx.x * 8 + wid; row < nrows; row += gridDim.x * 8) {
        f32x4 v[8];
#pragma unroll
        for (int i = 0; i < 8; ++i) v[i] = *reinterpret_cast<const f32x4*>(src + (long)row * DM + (lane + 64 * i) * 4);
        if constexpr (MOE) {
            const int2 ce = ne, cr = nr; const int nrow = row + gridDim.x * 8;
            if (nrow < nrows) { ne = *reinterpret_cast<const int2*>(WS_PTR(const int, WS_TOKE) + nrow * 2); nr = *reinterpret_cast<const int2*>(WS_PTR(const int, WS_TOKR) + nrow * 2); }
            const long s0 = offs[ce.x] + cr.x, s1 = offs[ce.y] + cr.y;
            const bf16* y0 = WS_PTR(const bf16, WS_YBUF) + s0 * DM; const bf16* y1 = WS_PTR(const bf16, WS_YBUF) + s1 * DM;
#pragma unroll
            for (int i = 0; i < 8; ++i) { const f32x4 a = unpack4(*reinterpret_cast<const u32x2*>(y0 + (lane + 64 * i) * 4));
                const f32x4 c = unpack4(*reinterpret_cast<const u32x2*>(y1 + (lane + 64 * i) * 4)); v[i] = v[i] + a + c; }
            if (hout) {
#pragma unroll
                for (int i = 0; i < 8; ++i) *reinterpret_cast<f32x4*>(hout + (long)row * DM + (lane + 64 * i) * 4) = v[i];
            }
        }
        float ss = 0.f;
#pragma unroll
        for (int i = 0; i < 8; ++i) ss += v[i][0] * v[i][0] + v[i][1] * v[i][1] + v[i][2] * v[i][2] + v[i][3] * v[i][3];
        ss = wave_sum(ss);
        const float inv = rsqrtf(ss * (1.f / DM) + 1e-6f);
#pragma unroll
        for (int i = 0; i < 8; ++i) { const f32x4 o = v[i] * inv * gv[i];
            if (dbf) *reinterpret_cast<u32x2*>(dbf + (long)row * DM + (lane + 64 * i) * 4) = pack4(o);
            if (df32) *reinterpret_cast<f32x4*>(df32 + (long)row * DM + (lane + 64 * i) * 4) = o; }
    }
}
__device__ __forceinline__ void moe_prefix(const Params& p, char* lds, const int l) {
    int* offs = (int*)(lds + L_PFX); int* toff = offs + 65;
    const int* cnt = WS_PTR(const int, CTL_CNT) + l * 64;
    __syncthreads();
    if (TID() < 65) { int a = 0, t = 0; for (int e = 0; e < (int)TID(); ++e) { const int c = cnt[e]; a += c; t += (c + 383) / 384; } offs[TID()] = a; toff[TID()] = t; }
    __syncthreads();
}

__device__ __forceinline__ void prologue_misc(const Params& p, char* lds) {
    const int tid = TID(); const long gtid = (long)blockIdx.x * NTHR + tid, gsz = (long)gridDim.x * NTHR;
    float* cosA = WS_PTR(float, WS_COSA); float* sinA = WS_PTR(float, WS_SINA); float* cosN = WS_PTR(float, WS_COSN); float* sinN = WS_PTR(float, WS_SINN);
    for (long i = gtid; i < (long)T * 48; i += gsz) {
        const int t = (int)(i / 48), f = (int)(i - (long)t * 48);
        const float ex = f < 32 ? (float)(2 * f) * (1.f / 64.f) : (float)(2 * (f - 32)) * (1.f / 32.f);
        const float invf = exp2f(-ex * 18.931568569324174f);
        const float ang = (float)p.positions[t] * invf;
        const float n = rintf(ang * 0.15915494309189535f);
        const float r = fmaf(n, 1.7484555e-7f, fmaf(-n, 6.2831855f, ang));
        const float c = __cosf(r), s = __sinf(r);
        if (f < 32) { cosA[t * 32 + f] = c; sinA[t * 32 + f] = s; } else { cosN[t * 16 + f - 32] = c; sinN[t * 16 + f - 32] = s; }
    }
    bf16* kc = WS_PTR(bf16, WS_KCMP);
    for (long i = gtid; i < 16 * 128; i += gsz) kc[((i >> 7) * 128 + 127) * 128 + (i & 127)] = __float2bfloat16(0.f);
    float* part = WS_PTR(float, WS_B1PART);
    for (int u = blockIdx.x; u < 64; u += gridDim.x) {
        const int v = u >> 4, kp = u & 15, l = v >> 1, which = v & 1;
        const float* pe = (which ? p.pe_v : p.pe_k) + (long)l * 4096 + kp * 256; const float* w1 = (which ? p.w_cv1 : p.w_ck1) + (long)l * 4096 * 512 + (long)kp * 256 * 512 + tid;
        float a = 0.f;
#pragma unroll 16
        for (int k = 0; k < 256; ++k) a += pe[k] * w1[(long)k * 512];
        part[(v * 16 + kp) * 512 + tid] = a;
    }
}
__device__ __forceinline__ void bias1_finish(const Params& p) {
    const int gt = blockIdx.x * NTHR + TID();
    if (gt < 2048) { const float* part = WS_PTR(const float, WS_B1PART) + (gt >> 9) * 16 * 512 + (gt & 511); float a = 0.f;
#pragma unroll
        for (int q = 0; q < 16; ++q) a += part[q * 512];
        WS_PTR(float, WS_BIAS1)[gt] = a; }
}

__device__ __forceinline__ void phase_post(const Params& p, const int l) {
    const int tid = TID(), wid = tid >> 6, lane = tid & 63;
    const float* proj = WS_PTR(const float, WS_PROJ);
    const float* cosA = WS_PTR(const float, WS_COSA); const float* sinA = WS_PTR(const float, WS_SINA);
    const float* cosN = WS_PTR(const float, WS_COSN); const float* sinN = WS_PTR(const float, WS_SINN);
    bf16* cqn = WS_PTR(bf16, WS_CQN); bf16* ckvn = WS_PTR(bf16, WS_CKVN); bf16* kmla = WS_PTR(bf16, WS_KMLA); bf16* qn = WS_PTR(bf16, WS_QN);
    bf16* kv6 = WS_PTR(bf16, WS_KV6); float* gates = WS_PTR(float, WS_GATES);
    const float* gcq = p.g_cq + l * 512; const float* gckv = p.g_ckv + l * 256;
    for (int t = blockIdx.x * 8 + wid; t < T; t += gridDim.x * 8) {
        const float* pr = proj + (long)t * DINP;
        {
            const f32x4 a0 = *reinterpret_cast<const f32x4*>(pr + C_CQ + lane * 4), a1 = *reinterpret_cast<const f32x4*>(pr + C_CQ + 256 + lane * 4);
            float ss = a0[0] * a0[0] + a0[1] * a0[1] + a0[2] * a0[2] + a0[3] * a0[3] + a1[0] * a1[0] + a1[1] * a1[1] + a1[2] * a1[2] + a1[3] * a1[3];
            ss = wave_sum(ss); const float inv = rsqrtf(ss * (1.f / 512.f) + 1e-6f);
            const f32x4 g0 = *reinterpret_cast<const f32x4*>(gcq + lane * 4), g1 = *reinterpret_cast<const f32x4*>(gcq + 256 + lane * 4);
            *reinterpret_cast<u32x2*>(cqn + (long)t * 512 + lane * 4) = pack4(a0 * inv * g0);
            *reinterpret_cast<u32x2*>(cqn + (long)t * 512 + 256 + lane * 4) = pack4(a1 * inv * g1);
        }
        {
            const f32x4 a0 = *reinterpret_cast<const f32x4*>(pr + C_CKV + lane * 4);
            float ss = a0[0] * a0[0] + a0[1] * a0[1] + a0[2] * a0[2] + a0[3] * a0[3];
            ss = wave_sum(ss); const float inv = rsqrtf(ss * (1.f / 256.f) + 1e-6f);
            const f32x4 g0 = *reinterpret_cast<const f32x4*>(gckv + lane * 4);
            *reinterpret_cast<u32x2*>(ckvn + (long)t * 256 + lane * 4) = pack4(a0 * inv * g0);
        }
        {
            const int i = lane & 31; const float x1 = pr[C_KR + i], x2 = pr[C_KR + 32 + i];
            const float c = cosA[(long)t * 32 + i], s = sinA[(long)t * 32 + i];
            const float v = lane < 32 ? x1 * c - x2 * s : x2 * c + x1 * s; const float vn = swap1(v);
            if (!(lane & 1)) { const unsigned w = cvtpk(v, vn);
#pragma unroll
                for (int h = 0; h < 8; ++h) *(unsigned*)(kmla + ((long)t * 8 + h) * 192 + 128 + lane) = w; }
        }
        {
            const int head = lane >> 3, part = lane & 7; const float* qp = pr + C_QN + head * 128 + part * 16;
            f32x4 q[4];
#pragma unroll
            for (int e = 0; e < 4; ++e) q[e] = *reinterpret_cast<const f32x4*>(qp + e * 4);
            float o[16];
#pragma unroll
            for (int e = 0; e < 16; ++e) { const float mine = q[e >> 2][e & 3]; const float oth = swap1(mine);
                const float c = cosN[(long)t * 16 + e], s = sinN[(long)t * 16 + e];
                o[e] = part == 0 ? mine * c - oth * s : (part == 1 ? mine * c + oth * s : mine); }
            u32x4 w0 = {cvtpk(o[0], o[1]), cvtpk(o[2], o[3]), cvtpk(o[4], o[5]), cvtpk(o[6], o[7])};
            u32x4 w1 = {cvtpk(o[8], o[9]), cvtpk(o[10], o[11]), cvtpk(o[12], o[13]), cvtpk(o[14], o[15])};
            bf16* d = qn + ((long)t * 8 + head) * 128 + part * 16;
            *reinterpret_cast<u32x4*>(d) = w0; *reinterpret_cast<u32x4*>(d + 8) = w1;
        }
#pragma unroll
        for (int X = 0; X < 6; ++X) {
            const f32x4 a = *reinterpret_cast<const f32x4*>(pr + C_KC + X * 256 + lane * 4);
            f32x4 o = a;
            if ((X & 1) == 0) {
                const int dl = (lane & 31) * 4;
#pragma unroll
                for (int e = 0; e < 4; ++e) { const float oth = __shfl_xor(a[e], 4); const int f = (dl & 15) + e;
                    const float c = cosN[(long)t * 16 + f], s = sinN[(long)t * 16 + f];
                    o[e] = dl < 16 ? a[e] * c - oth * s : (dl < 32 ? a[e] * c + oth * s : a[e]); }
            }
            *reinterpret_cast<u32x2*>(kv6 + X * KV6_STRIDE + (long)t * 256 + lane * 4) = pack4(o);
        }
        if (lane < 24) gates[(long)t * 24 + lane] = 1.f / (1.f + __expf(-pr[C_GT + lane]));
    }
}

__device__ __forceinline__ void phase_combine(const Params& p, const int l) {
    const int tid = TID(), wid = tid >> 6, lane = tid & 63;
    const bf16* ya = WS_PTR(const bf16, WS_YMLA); const float* yb = WS_PTR(const float, WS_YNSA); bf16* y = WS_PTR(bf16, WS_Y);
    const float* ga = p.g_ya + l * 1024 + lane * 16; const float* gb = p.g_yb + l * 1024 + lane * 16;
    for (int t = blockIdx.x * 8 + wid; t < T; t += gridDim.x * 8) {
        float a[16], c[16];
        { const u32x4 w0 = *reinterpret_cast<const u32x4*>(ya + (long)t * 1024 + lane * 16), w1 = *reinterpret_cast<const u32x4*>(ya + (long)t * 1024 + lane * 16 + 8);
#pragma unroll
          for (int e = 0; e < 4; ++e) { a[2 * e] = bflo(w0[e]); a[2 * e + 1] = bfhi(w0[e]); a[8 + 2 * e] = bflo(w1[e]); a[8 + 2 * e + 1] = bfhi(w1[e]); } }
#pragma unroll
        for (int e = 0; e < 4; ++e) { const f32x4 q = *reinterpret_cast<const f32x4*>(yb + (long)t * 1024 + lane * 16 + e * 4); c[4 * e] = q[0]; c[4 * e + 1] = q[1]; c[4 * e + 2] = q[2]; c[4 * e + 3] = q[3]; }
        float sa = 0.f, sb = 0.f;
#pragma unroll
        for (int e = 0; e < 16; ++e) { sa += a[e] * a[e]; sb += c[e] * c[e]; }
        sa = wave_sum(sa); sb = wave_sum(sb);
        const float ia = rsqrtf(sa * (1.f / 1024.f) + 1e-6f), ib = rsqrtf(sb * (1.f / 1024.f) + 1e-6f);
        unsigned wa[8], wb[8];
#pragma unroll
        for (int e = 0; e < 8; ++e) { wa[e] = cvtpk(a[2 * e] * ia * ga[2 * e], a[2 * e + 1] * ia * ga[2 * e + 1]); wb[e] = cvtpk(c[2 * e] * ib * gb[2 * e], c[2 * e + 1] * ib * gb[2 * e + 1]); }
        bf16* d = y + (long)t * 2048 + lane * 16;
        *reinterpret_cast<u32x4*>(d) = u32x4{wa[0], wa[1], wa[2], wa[3]}; *reinterpret_cast<u32x4*>(d + 8) = u32x4{wa[4], wa[5], wa[6], wa[7]};
        *reinterpret_cast<u32x4*>(d + 1024) = u32x4{wb[0], wb[1], wb[2], wb[3]}; *reinterpret_cast<u32x4*>(d + 1032) = u32x4{wb[4], wb[5], wb[6], wb[7]};
    }
}


constexpr int VG_ABLK = 128 * 128, VG_STAGE = 3 * VG_ABLK + 128 * 128;
struct VgStage { f32x4 b[4]; float g[4]; };
template <int VAR, int NBC, class AF, class BF, class EF>
__device__ __forceinline__ void vgemm_tile_n(char* lds, const int nk, const int nblk_rt, const AF& af, const BF& bf, const EF& ef) {
    const int nblk = NBC > 0 ? NBC : __builtin_amdgcn_readfirstlane(nblk_rt);
    const int tid = TID(), lane = tid & 63, wid = tid >> 6;
    const int wm = wid >> 1, wn = wid & 1;
    const int ac = tid & 7, ar0 = tid >> 3;
    const char* abase = (const char*)af.base; unsigned aoff[3][2];
#pragma unroll
    for (int b = 0; b < 3; ++b)
#pragma unroll
        for (int i = 0; i < 2; ++i) aoff[b][i] = (unsigned)((const char*)(af.row(b * 128 + ar0 + 64 * i) + ac * 8) - abase);
    const int alds0 = ar0 * 128 + ((ac ^ ((ar0 >> 1) & 7)) << 4);
    const int n4 = tid & 31, kg = tid >> 5;
    long ldb = 0; const float* bptr = bf.col(n4 * 4, ldb);
    int blds[4];
#pragma unroll
    for (int e = 0; e < 4; ++e) { const int n = n4 * 4 + e; const int sw = (n >> 1) & 7; blds[e] = 3 * VG_ABLK + n * 128 + ((((kg >> 1) ^ sw) << 4) + (kg & 1) * 8); }
    VgStage S0, S1; bf16x8 As[3][2];
#define VG_GLOADA(SS, kt) do {                                                                                                 \
        _Pragma("unroll") for (int b = 0; b < 3; ++b) { if (b < nblk) { _Pragma("unroll") for (int i = 0; i < 2; ++i) asm volatile("global_load_dwordx4 %0, %1, off" : "=v"(As[b][i]) : "v"(abase + aoff[b][i] + (kt) * 128) : "memory"); } } } while (0)
#define VG_GLOADB(SS, kt) do {                                                                                                 \
        _Pragma("unroll") for (int kk = 0; kk < 4; ++kk) { asm volatile("global_load_dwordx4 %0, %1, off nt" : "=v"(SS.b[kk]) : "v"(bptr + (long)((kt) * 64 + kg * 4 + kk) * ldb) : "memory"); } } while (0)
#define VG_GLOAD(SS, kt) do { VG_GLOADA(SS, kt); VG_GLOADB(SS, kt); } while (0)
#define VG_LSTORE(SS, buf) do {                                                                                                \
        _Pragma("unroll") for (int b = 0; b < 3; ++b) { if (b < nblk) { _Pragma("unroll") for (int i = 0; i < 2; ++i) *reinterpret_cast<bf16x8*>((buf) + b * VG_ABLK + alds0 + i * 64 * 128) = As[b][i]; } } \
        _Pragma("unroll") for (int e = 0; e < 4; ++e) { u32x2 w = {cvtpk(SS.b[0][e], SS.b[1][e]), cvtpk(SS.b[2][e], SS.b[3][e])}; *reinterpret_cast<u32x2*>((buf) + blds[e]) = w; } } while (0)
    f32x4 acc[3][2][4];
#pragma unroll
    for (int b = 0; b < 3; ++b)
#pragma unroll
        for (int i = 0; i < 2; ++i)
#pragma unroll
            for (int j = 0; j < 4; ++j) acc[b][i][j] = f32x4{0.f, 0.f, 0.f, 0.f};
    const int fsw = (lane >> 1) & 7, fq = lane >> 4;
    const int foff0 = (lane & 15) * 128 + (((0 + fq) ^ fsw) << 4), foff1 = (lane & 15) * 128 + (((4 + fq) ^ fsw) << 4);
#define VG_COMPUTE(buf) do {                                                                                                   \
        _Pragma("unroll") for (int ks = 0; ks < 2; ++ks) { const int fo = ks ? foff1 : foff0; bf16x8 bb[4];                    \
            _Pragma("unroll") for (int j = 0; j < 4; ++j) bb[j] = *reinterpret_cast<const bf16x8*>((buf) + 3 * VG_ABLK + (wn * 64 + j * 16) * 128 + fo); \
            _Pragma("unroll") for (int b = 0; b < 3; ++b) { if (b < nblk) { bf16x8 aa[2];                                      \
                _Pragma("unroll") for (int i = 0; i < 2; ++i) aa[i] = *reinterpret_cast<const bf16x8*>((buf) + b * VG_ABLK + (wm * 32 + i * 16) * 128 + fo); \
                _Pragma("unroll") for (int i = 0; i < 2; ++i) { _Pragma("unroll") for (int j = 0; j < 4; ++j)                  \
                    acc[b][i][j] = __builtin_amdgcn_mfma_f32_16x16x32_bf16(aa[i], bb[j], acc[b][i][j], 0, 0, 0); } } } } } while (0)
    char* buf0 = lds; char* buf1 = lds + VG_STAGE;
#define VGW(SS, later) do { if (later) asm volatile("s_waitcnt vmcnt(4)" ::: "memory"); else asm volatile("s_waitcnt vmcnt(0)" ::: "memory");             \
                                       \
        _Pragma("unroll") for (int b = 0; b < 3; ++b) { if (b < nblk) { _Pragma("unroll") for (int i = 0; i < 2; ++i) asm volatile("" : "+v"(As[b][i])); } }          \
        _Pragma("unroll") for (int kk = 0; kk < 4; ++kk) asm volatile("" : "+v"(SS.b[kk])); } while (0)
#define VGLA(kt) do { if constexpr (VAR == 3) { if ((kt) < 1) VG_GLOADA(S0, kt); } else VG_GLOADA(S0, kt); } while (0)
#define VGLB(SS, kt) do { if constexpr (VAR == 2) { if ((kt) < 2) VG_GLOADB(SS, kt); } else VG_GLOADB(SS, kt); } while (0)
#define VGS(SS, buf) do { if constexpr (VAR != 4) VG_LSTORE(SS, buf); } while (0)
#define VGC(buf) do { if constexpr (VAR != 1) VG_COMPUTE(buf); } while (0)
    asm volatile("s_waitcnt vmcnt(0)" ::: "memory");
    VGLA(0); VGLB(S0, 0); if (nk > 1) VGLB(S1, 1);
    VGW(S0, nk > 1); VG_LSTORE(S0, buf0); if (nk > 1) VGLA(1); if (nk > 2) VGLB(S0, 2);
    __syncthreads();
    for (int kt = 0; kt < nk; kt += 2) {
        VGC(buf0);
        if (kt + 1 < nk) { VGW(S1, kt + 2 < nk); VGS(S1, buf1); if (kt + 2 < nk) VGLA(kt + 2); if (kt + 3 < nk) VGLB(S1, kt + 3); }
        __syncthreads();
        if (kt + 1 < nk) {
            VGC(buf1);
            if (kt + 2 < nk) { VGW(S0, kt + 3 < nk); VGS(S0, buf0); if (kt + 3 < nk) VGLA(kt + 3); if (kt + 4 < nk) VGLB(S0, kt + 4); }
            __syncthreads();
        }
    }
    asm volatile("s_waitcnt vmcnt(0)" ::: "memory");
#undef VGW
#undef VGLA
#undef VGLB
#undef VGS
#undef VGC
#undef VG_GLOAD
#undef VG_GLOADA
#undef VG_GLOADB
#undef VG_LSTORE
#undef VG_COMPUTE
#pragma unroll
    for (int b = 0; b < 3; ++b) if (b < nblk) ef.run(b, acc[b], wm, wn, lane);
}

template <int NB, class AF, class BF, class EF>
__device__ __forceinline__ void hgemm_tile(char* lds_, const int nk, const AF& af, const BF& bf, const EF& ef) {
    LAS char* lds = (LAS char*)lds_;
    const int tid = TID(), lane = tid & 63, wid = __builtin_amdgcn_readfirstlane(tid >> 6);
    const int wm = wid >> 1, wn = wid & 1;
    const char* abase = (const char*)af.base; unsigned aoff[NB][2];
#pragma unroll
    for (int b = 0; b < NB; ++b)
#pragma unroll
        for (int i = 0; i < 2; ++i) { const int rb = (wid * 2 + i) * 8 + (lane >> 3);
            aoff[b][i] = (unsigned)((const char*)af.row(b * 128 + rb) - abase) + (unsigned)(((lane & 7) ^ ((rb >> 1) & 7)) * 16); }
    const int n4 = tid & 31, kg = tid >> 5;
    long ldb = 0; const float* bptr = bf.col(n4 * 4, ldb);
    int blds[4];
#pragma unroll
    for (int e = 0; e < 4; ++e) { const int n = n4 * 4 + e; const int sw = (n >> 1) & 7; blds[e] = 3 * VG_ABLK + n * 128 + ((((kg >> 1) ^ sw) << 4) + (kg & 1) * 8); }
    f32x4 S0[4], S1[4];
#define HG_DMA_A(buf, kt) do { _Pragma("unroll") for (int b = 0; b < NB; ++b) { _Pragma("unroll") for (int i = 0; i < 2; ++i)                      \
        __builtin_amdgcn_global_load_lds((const unsigned*)(abase + aoff[b][i] + (size_t)af.koff((kt) * 64) * 2), (LAS unsigned*)((buf) + b * VG_ABLK + (wid * 2 + i) * 1024), 16, 0, 0); } } while (0)
#define HG_LOADB(SS, kt) do { _Pragma("unroll") for (int kk = 0; kk < 4; ++kk)                                                                    \
        asm volatile("global_load_dwordx4 %0, %1, off nt" : "=v"(SS[kk]) : "v"(bptr + (long)((kt) * 64 + kg * 4 + kk) * ldb) : "memory"); } while (0)
#define HG_STOREB(SS, buf) do { _Pragma("unroll") for (int kk = 0; kk < 4; ++kk) asm volatile("" : "+v"(SS[kk]));                                 \
        _Pragma("unroll") for (int e = 0; e < 4; ++e) { u32x2 w = {cvtpk(SS[0][e], SS[1][e]), cvtpk(SS[2][e], SS[3][e])}; *(LAS u32x2*)((buf) + blds[e]) = w; } } while (0)
#define HG_WAIT(n) asm volatile("s_waitcnt vmcnt(%0)" :: "n"(n) : "memory")
#define HG_BAR() do { asm volatile("s_waitcnt lgkmcnt(0)" ::: "memory"); __builtin_amdgcn_s_barrier(); asm volatile("" ::: "memory"); } while (0)
    f32x4 acc[NB][2][4];
#pragma unroll
    for (int b = 0; b < NB; ++b)
#pragma unroll
        for (int i = 0; i < 2; ++i)
#pragma unroll
            for (int j = 0; j < 4; ++j) acc[b][i][j] = f32x4{0.f, 0.f, 0.f, 0.f};
    const int fsw = (lane >> 1) & 7, fq = lane >> 4;
    const int foff0 = (lane & 15) * 128 + (((0 + fq) ^ fsw) << 4), foff1 = (lane & 15) * 128 + (((4 + fq) ^ fsw) << 4);
#define HG_COMPUTE(buf) do {                                                                                                   \
        bf16x8 bb0[4], bb1[4], aa0[NB][2], aa1[NB][2];                                                                         \
        _Pragma("unroll") for (int j = 0; j < 4; ++j) bb0[j] = *(const LAS bf16x8*)((buf) + 3 * VG_ABLK + (wn * 64 + j * 16) * 128 + foff0); \
        _Pragma("unroll") for (int b = 0; b < NB; ++b) { _Pragma("unroll") for (int i = 0; i < 2; ++i) aa0[b][i] = *(const LAS bf16x8*)((buf) + b * VG_ABLK + (wm * 32 + i * 16) * 128 + foff0); } \
        _Pragma("unroll") for (int j = 0; j < 4; ++j) bb1[j] = *(const LAS bf16x8*)((buf) + 3 * VG_ABLK + (wn * 64 + j * 16) * 128 + foff1); \
        _Pragma("unroll") for (int b = 0; b < NB; ++b) { _Pragma("unroll") for (int i = 0; i < 2; ++i) aa1[b][i] = *(const LAS bf16x8*)((buf) + b * VG_ABLK + (wm * 32 + i * 16) * 128 + foff1); } \
        _Pragma("unroll") for (int b = 0; b < NB; ++b) { _Pragma("unroll") for (int i = 0; i < 2; ++i) { _Pragma("unroll") for (int j = 0; j < 4; ++j) \
            acc[b][i][j] = __builtin_amdgcn_mfma_f32_16x16x32_bf16(aa0[b][i], bb0[j], acc[b][i][j], 0, 0, 0); } }              \
        _Pragma("unroll") for (int b = 0; b < NB; ++b) { _Pragma("unroll") for (int i = 0; i < 2; ++i) { _Pragma("unroll") for (int j = 0; j < 4; ++j) \
            acc[b][i][j] = __builtin_amdgcn_mfma_f32_16x16x32_bf16(aa1[b][i], bb1[j], acc[b][i][j], 0, 0, 0); } } } while (0)
#define HG_STEP(t, CUR, NXT, SN) do {                                                                                          \
        if ((t) + 1 < nk) HG_DMA_A(NXT, (t) + 1);                                                                              \
        HG_COMPUTE(CUR);                                                                                                       \
        if ((t) + 1 < nk) {                                                                                                    \
            if ((t) + 2 < nk) HG_WAIT(4 + 2 * NB); else HG_WAIT(2 * NB);           \
            HG_STOREB(SN, NXT);                                                                                                \
            if ((t) + 3 < nk) { HG_LOADB(SN, (t) + 3); HG_WAIT(4); } else HG_WAIT(0);                        \
        }                                                                                                                      \
        HG_BAR(); } while (0)
    LAS char* buf0 = lds; LAS char* buf1 = lds + VG_STAGE;
    asm volatile("s_waitcnt vmcnt(0) lgkmcnt(0)" ::: "memory"); __builtin_amdgcn_s_barrier(); asm volatile("" ::: "memory");
    HG_DMA_A(buf0, 0); HG_LOADB(S0, 0);
    if (nk > 1) { HG_LOADB(S1, 1); HG_WAIT(4); } else HG_WAIT(0);
    HG_STOREB(S0, buf0);
    if (nk > 2) HG_LOADB(S0, 2);
    HG_BAR();
    for (int kt = 0; kt < nk; kt += 2) {
        HG_STEP(kt, buf0, buf1, S1);
        if (kt + 1 < nk) HG_STEP(kt + 1, buf1, buf0, S0);
    }
    asm volatile("s_waitcnt vmcnt(0)" ::: "memory");
#undef HG_DMA_A
#undef HG_LOADB
#undef HG_STOREB
#undef HG_WAIT
#undef HG_BAR
#undef HG_COMPUTE
#undef HG_STEP
#pragma unroll
    for (int b = 0; b < NB; ++b) ef.run(b, acc[b], wm, wn, lane);
}

template <int NB, class AF, class BF, class EF>
__device__ __forceinline__ void hgemm3s_tile(char* lds_, const int nk, const AF& af, const BF& bf, const EF& ef) {
    constexpr int STG = (NB + 1) * VG_ABLK;
    static_assert(3 * STG <= L_TOP, "ring");
    LAS char* lds = (LAS char*)lds_;
    const int tid = TID(), lane = tid & 63, wid = __builtin_amdgcn_readfirstlane(tid >> 6);
    const int wm = wid >> 1, wn = wid & 1;
    const char* abase = (const char*)af.base; unsigned aoff[NB][2];
#pragma unroll
    for (int b = 0; b < NB; ++b)
#pragma unroll
        for (int i = 0; i < 2; ++i) { const int rb = (wid * 2 + i) * 8 + (lane >> 3);
            aoff[b][i] = (unsigned)((const char*)af.row(b * 128 + rb) - abase) + (unsigned)(((lane & 7) ^ ((rb >> 1) & 7)) * 16); }
    const int n4 = tid & 31, kg = tid >> 5;
    long ldb = 0; const float* bptr = bf.col(n4 * 4, ldb);
    int blds[4];
#pragma unroll
    for (int e = 0; e < 4; ++e) { const int n = n4 * 4 + e; const int sw = (n >> 1) & 7; blds[e] = NB * VG_ABLK + n * 128 + ((((kg >> 1) ^ sw) << 4) + (kg & 1) * 8); }
    f32x4 S0[4], S1[4];
#define H1_DMA_A(st, kt) do { _Pragma("unroll") for (int b = 0; b < NB; ++b) { _Pragma("unroll") for (int i = 0; i < 2; ++i)                    \
        __builtin_amdgcn_global_load_lds((const unsigned*)(abase + aoff[b][i] + (size_t)af.koff((kt) * 64) * 2), (LAS unsigned*)(lds + (st) * STG + b * VG_ABLK + (wid * 2 + i) * 1024), 16, 0, 0); } } while (0)
#define H1_LOADB(SS, kt) do { _Pragma("unroll") for (int kk = 0; kk < 4; ++kk)                                                                    \
        asm volatile("global_load_dwordx4 %0, %1, off nt" : "=v"(SS[kk]) : "v"(bptr + (long)((kt) * 64 + kg * 4 + kk) * ldb) : "memory"); } while (0)
#define H1_STOREB(SS, st) do { _Pragma("unroll") for (int kk = 0; kk < 4; ++kk) asm volatile("" : "+v"(SS[kk]));                                  \
        _Pragma("unroll") for (int e = 0; e < 4; ++e) { u32x2 w = {cvtpk(SS[0][e], SS[1][e]), cvtpk(SS[2][e], SS[3][e])}; *(LAS u32x2*)(lds + (st) * STG + blds[e]) = w; } } while (0)
#define H1_WAIT(n) asm volatile("s_waitcnt vmcnt(%0)" :: "n"(n) : "memory")
#define H1_BAR() do { asm volatile("s_waitcnt lgkmcnt(0)" ::: "memory"); __builtin_amdgcn_s_barrier(); asm volatile("" ::: "memory"); } while (0)
    f32x4 acc[NB][2][4];
#pragma unroll
    for (int b = 0; b < NB; ++b)
#pragma unroll
        for (int i = 0; i < 2; ++i)
#pragma unroll
            for (int j = 0; j < 4; ++j) acc[b][i][j] = f32x4{0.f, 0.f, 0.f, 0.f};
    const int fsw = (lane >> 1) & 7, fq = lane >> 4;
    const int foff0 = (lane & 15) * 128 + (((0 + fq) ^ fsw) << 4), foff1 = (lane & 15) * 128 + (((4 + fq) ^ fsw) << 4);
#define H1_COMPUTE(st) do { const LAS char* sb_ = lds + (st) * STG;                                                          \
        bf16x8 bb0[4], bb1[4], aa0[NB][2], aa1[NB][2];                                                                         \
        _Pragma("unroll") for (int j = 0; j < 4; ++j) bb0[j] = *(const LAS bf16x8*)(sb_ + NB * VG_ABLK + (wn * 64 + j * 16) * 128 + foff0); \
        _Pragma("unroll") for (int b = 0; b < NB; ++b) { _Pragma("unroll") for (int i = 0; i < 2; ++i) aa0[b][i] = *(const LAS bf16x8*)(sb_ + b * VG_ABLK + (wm * 32 + i * 16) * 128 + foff0); } \
        _Pragma("unroll") for (int j = 0; j < 4; ++j) bb1[j] = *(const LAS bf16x8*)(sb_ + NB * VG_ABLK + (wn * 64 + j * 16) * 128 + foff1); \
        _Pragma("unroll") for (int b = 0; b < NB; ++b) { _Pragma("unroll") for (int i = 0; i < 2; ++i) aa1[b][i] = *(const LAS bf16x8*)(sb_ + b * VG_ABLK + (wm * 32 + i * 16) * 128 + foff1); } \
        _Pragma("unroll") for (int b = 0; b < NB; ++b) { _Pragma("unroll") for (int i = 0; i < 2; ++i) { _Pragma("unroll") for (int j = 0; j < 4; ++j) \
            acc[b][i][j] = __builtin_amdgcn_mfma_f32_16x16x32_bf16(aa0[b][i], bb0[j], acc[b][i][j], 0, 0, 0); } }              \
        _Pragma("unroll") for (int b = 0; b < NB; ++b) { _Pragma("unroll") for (int i = 0; i < 2; ++i) { _Pragma("unroll") for (int j = 0; j < 4; ++j) \
            acc[b][i][j] = __builtin_amdgcn_mfma_f32_16x16x32_bf16(aa1[b][i], bb1[j], acc[b][i][j], 0, 0, 0); } } } while (0)
#define H1_STEP(t, ST, SN, SN2, SN_) do { if ((t) < nk) {                                                                      \
        if ((t) + 2 < nk) H1_DMA_A(SN2, (t) + 2);                                                                              \
        H1_COMPUTE(ST);                                                                                                        \
        if ((t) + 1 < nk) {                                                                                                    \
            if ((t) + 2 < nk) H1_WAIT(4 + 2 * NB); else H1_WAIT(0);       \
            H1_STOREB(SN_, SN);                                                                                                \
            if ((t) + 3 < nk) H1_LOADB(SN_, (t) + 3);                                                                          \
        }                                                                                                                      \
        H1_BAR(); } } while (0)
    asm volatile("s_waitcnt vmcnt(0) lgkmcnt(0)" ::: "memory"); __builtin_amdgcn_s_barrier(); asm volatile("" ::: "memory");
    H1_DMA_A(0, 0); if (nk > 1) H1_DMA_A(1, 1);
    H1_LOADB(S0, 0); if (nk > 1) H1_LOADB(S1, 1);
    if (nk > 1) H1_WAIT(4); else H1_WAIT(0);
    H1_STOREB(S0, 0);
    if (nk > 2) H1_LOADB(S0, 2);
    H1_BAR();
    for (int kt = 0; kt < nk; kt += 6) {
        H1_STEP(kt, 0, 1, 2, S1);
        H1_STEP(kt + 1, 1, 2, 0, S0);
        H1_STEP(kt + 2, 2, 0, 1, S1);
        H1_STEP(kt + 3, 0, 1, 2, S0);
        H1_STEP(kt + 4, 1, 2, 0, S1);
        H1_STEP(kt + 5, 2, 0, 1, S0);
    }
    asm volatile("s_waitcnt vmcnt(0)" ::: "memory");
#undef H1_DMA_A
#undef H1_LOADB
#undef H1_STOREB
#undef H1_WAIT
#undef H1_BAR
#undef H1_COMPUTE
#undef H1_STEP
#pragma unroll
    for (int b = 0; b < NB; ++b) ef.run(b, acc[b], wm, wn, lane);
}
template <class AF, class BF, class EF>
__device__ __forceinline__ void hgemm1_tile(char* lds_, const int nk, const AF& af, const BF& bf, const EF& ef) { hgemm3s_tile<1>(lds_, nk, af, bf, ef); }
struct AVGather {
    const bf16* base; const int* list; int r0, cnt;
    __device__ __forceinline__ const bf16* row(int r) const { int R = r0 + r; R = R < cnt ? R : cnt - 1; return base + (long)list[R] * DM; }
    __device__ __forceinline__ long koff(int k0) const { return k0; }
};
struct AVPlain {
    const bf16* base; long ld; int nrows;
    __device__ __forceinline__ const bf16* row(int r) const { const int R = r < nrows ? r : nrows - 1; return base + (long)R * ld; }
    __device__ __forceinline__ long koff(int k0) const { return k0; }
};
struct HEpiBf16 {
    bf16* Cc; long ldc; int m0, n0, mmax; const float* rinv;
    __device__ __forceinline__ void run(int, f32x4 (&acc)[2][4], int wm, int wn, int lane) const {
#pragma unroll
        for (int i = 0; i < 2; ++i)
#pragma unroll
            for (int r = 0; r < 4; ++r) { const int trow = wm * 32 + i * 16 + (lane >> 4) * 4 + r, R = m0 + trow; const bool ok = R < mmax; const float ri = rinv ? rinv[trow] : 1.f;
#pragma unroll
                for (int j = 0; j < 4; ++j) { const float v = acc[i][j][r] * ri; const float vn = swap1(v);
                    if (ok && !(lane & 1)) *(unsigned*)(Cc + (long)R * ldc + n0 + wn * 64 + j * 16 + (lane & 15)) = cvtpk(v, vn); } }
    }
};
struct HEpiF32 {
    float* Cc; long ldc; int m0, n0, mmax;
    __device__ __forceinline__ void run(int, f32x4 (&acc)[2][4], int wm, int wn, int lane) const {
#pragma unroll
        for (int i = 0; i < 2; ++i)
#pragma unroll
            for (int r = 0; r < 4; ++r) { const int R = m0 + wm * 32 + i * 16 + (lane >> 4) * 4 + r;
                if (R < mmax) {
#pragma unroll
                    for (int j = 0; j < 4; ++j) Cc[(long)R * ldc + n0 + wn * 64 + j * 16 + (lane & 15)] = acc[i][j][r]; } }
    }
};
struct BVGateUp { const float* W1; const float* W3; int n0; const float* gk;
    __device__ __forceinline__ const float* col(int c, long& ldo) const { ldo = 512; const int wn = c >> 6, w = c & 63;
        const long d = (w & 32) ? (long)(W3 - W1) : 0L; return W1 + d + n0 + wn * 32 + (w & 31); } };
struct BVPlain { const float* W; long ld; int n0; const float* gk;
    __device__ __forceinline__ const float* col(int c, long& ldo) const { ldo = ld; return W + n0 + c; } };
struct EVMoe1 {
    bf16* hb; const float* rinv; int n0, valid;
    __device__ __forceinline__ void run(int b, f32x4 (&acc)[2][4], int wm, int wn, int lane) const {
#pragma unroll
        for (int i = 0; i < 2; ++i)
#pragma unroll
            for (int r = 0; r < 4; ++r) { const int row = b * 128 + wm * 32 + i * 16 + (lane >> 4) * 4 + r; const bool ok = row < valid;
                const float ri = ok ? rinv[row] : 0.f;
#pragma unroll
                for (int j = 0; j < 2; ++j) { const float g = acc[i][j][r] * ri, u = acc[i][j + 2][r] * ri; const float v = g / (1.f + __expf(-g)) * u; const float vn = swap1(v);
                    if (ok && !(lane & 1)) *(unsigned*)(hb + (long)row * 512 + n0 + wn * 32 + j * 16 + (lane & 15)) = cvtpk(v, vn); } }
    }
};
struct EVMoe2 {
    bf16* yb; const float* gate; int n0, valid;
    __device__ __forceinline__ void run(int b, f32x4 (&acc)[2][4], int wm, int wn, int lane) const {
#pragma unroll
        for (int i = 0; i < 2; ++i)
#pragma unroll
            for (int r = 0; r < 4; ++r) { const int row = b * 128 + wm * 32 + i * 16 + (lane >> 4) * 4 + r; const bool ok = row < valid; const float gt = ok ? gate[row] : 0.f;
#pragma unroll
                for (int j = 0; j < 4; ++j) { const float v = acc[i][j][r] * gt; const float vn = swap1(v);
                    if (ok && !(lane & 1)) *(unsigned*)(yb + (long)row * DM + n0 + wn * 64 + j * 16 + (lane & 15)) = cvtpk(v, vn); } }
    }
};

namespace pg8 {
#define PG8_LAS __attribute__((address_space(3)))
typedef unsigned short bf16_t;
constexpr int BM = 256, BK = 64, HALF = 128, HTB = HALF * BK * 2, STAGE_BYTES = 8 * HTB, NXCD = 8, WGM = 8;
__host__ __device__ __forceinline__ int lds_byte(int r, int c) { const int st = (r >> 4) * 2 + (c >> 5), rr = r & 15, cc = c & 31, ob = rr * 64 + cc * 2; return st * 1024 + (ob ^ (((ob >> 9) & 1) << 5)); }
__host__ __device__ __forceinline__ void stage_rc(int b, int& R, int& C) { const int st = b / 1024, sb = b % 1024, swz = sb ^ (((sb >> 9) & 1) << 5); R = (st >> 1) * 16 + swz / 64; C = (st & 1) * 32 + (swz % 64) / 2; }
__host__ __device__ __forceinline__ int perm32(int rho) { const int n = rho >> 4, i = rho & 15; return 8 * (i >> 2) + 4 * n + (i & 3); }
struct Unit { int pm, pn; };
struct Gemm { const bf16_t* A; const bf16_t* Bt; int M, N, K; };
struct StaticOrder {
    int nM, nN, nwg, G, c;
    __host__ __device__ void init(int M, int N, int G_, int c_) { nM = M / BM; nN = N / BM; nwg = nM * nN; G = G_; c = c_; }
    __host__ __device__ bool next(int i, Unit& u) const {
        const long L = (long)i * G + c; if (L >= nwg) return false;
        int wgid = (int)L; { const int q = nwg / NXCD, r = nwg % NXCD, xcd = wgid % NXCD, off = wgid / NXCD; wgid = (xcd < r ? xcd * (q + 1) : r * (q + 1) + (xcd - r) * q) + off; }
        const int nig = WGM * nN, gid = wgid / nig, fm = gid * WGM, gsz = (nM - fm) < WGM ? (nM - fm) : WGM;
        u.pm = fm + ((wgid % nig) % gsz); u.pn = (wgid % nig) / gsz; return true;
    }
    __device__ __forceinline__ void a_ready(const Unit&) const {}
    __device__ __forceinline__ void done(const Unit&) const {}
};
struct EpiResH {
    static constexpr bool PERM = false;
    float* C; const float* R; bf16_t* HB; float* hssq; const float* YL; const float* G; int ldc;
    __device__ __forceinline__ void mid(f32x4 (&acc)[2][2][4][2], const Unit& u, int wr, int wc, int fr, int fq) const {
        if (!YL) return;
#pragma unroll
        for (int ai = 0; ai < 2; ++ai)
#pragma unroll
            for (int m = 0; m < 4; ++m) { const float ratio = YL[wr * 64 + ai * HALF + m * 16 + fr];
#pragma unroll
                for (int bj = 0; bj < 2; ++bj)
#pragma unroll
                    for (int n = 0; n < 2; ++n) acc[ai][bj][m][n] = acc[ai][bj][m][n] * ratio; }
    }
    __device__ __forceinline__ void operator()(const f32x4 (&acc)[2][2][4][2], const Unit& u, int wr, int wc, int fr, int fq) const {
        const int row0 = u.pm * BM + wr * 64 + fr, col0 = u.pn * BM + wc * 32 + 4 * fq;
        f32x4 gv[2][2];
#pragma unroll
        for (int bj = 0; bj < 2; ++bj)
#pragma unroll
            for (int n = 0; n < 2; ++n) gv[bj][n] = *(const f32x4*)(G + col0 + bj * HALF + n * 16);
#pragma unroll
        for (int ai = 0; ai < 2; ++ai) {
            f32x4 rv[4][2][2];
#pragma unroll
            for (int m = 0; m < 4; ++m) { const size_t ro = (size_t)(row0 + ai * HALF + m * 16) * ldc + col0;
#pragma unroll
                for (int bj = 0; bj < 2; ++bj)
#pragma unroll
                    for (int n = 0; n < 2; ++n) rv[m][bj][n] = *(const f32x4*)(R + ro + bj * HALF + n * 16); }
#pragma unroll
            for (int m = 0; m < 4; ++m) { const size_t t = (size_t)(row0 + ai * HALF + m * 16), ro = t * ldc + col0;
                const float sc = YL ? YL[256 + wr * 64 + ai * HALF + m * 16 + fr] : 1.f;
                float ss = 0.f;
#pragma unroll
                for (int bj = 0; bj < 2; ++bj)
#pragma unroll
                    for (int n = 0; n < 2; ++n) { const f32x4 v = acc[ai][bj][m][n] * sc + rv[m][bj][n];
                        *(f32x4*)(C + ro + bj * HALF + n * 16) = v;
                        ss += (v[0] * v[0] + v[1] * v[1]) + (v[2] * v[2] + v[3] * v[3]);
                        const f32x4 vg = v * gv[bj][n];
                        *(u32x2*)(HB + ro + bj * HALF + n * 16) = u32x2{cvtpk(vg[0], vg[1]), cvtpk(vg[2], vg[3])}; }
                ss += __shfl_xor(ss, 16); ss += __shfl_xor(ss, 32);
                if (fq == 0) hssq[t * 32 + u.pn * 4 + wc] = ss; }
            asm volatile("" ::: "memory");
        }
    }
};
template <class E> struct has_mid { static constexpr bool v = false; };
template <> struct has_mid<EpiResH> { static constexpr bool v = true; };
struct EpiBf16 {
    static constexpr bool PERM = true;
    bf16_t* O; int ldc;
    __device__ __forceinline__ void operator()(const f32x4 (&acc)[2][2][4][2], const Unit& u, int wr, int wc, int fr, int fq) const {
        const int row0 = u.pm * BM + wr * 64 + fr, col0 = u.pn * BM + wc * 32 + 8 * fq;
#pragma unroll
        for (int ai = 0; ai < 2; ++ai)
#pragma unroll
            for (int m = 0; m < 4; ++m) { bf16_t* rowp = O + (size_t)(row0 + ai * HALF + m * 16) * ldc + col0;
#pragma unroll
                for (int bj = 0; bj < 2; ++bj) { const f32x4 v0 = acc[ai][bj][m][0], v1 = acc[ai][bj][m][1];
                    u32x4 w; w.x = cvtpk(v0[0], v0[1]); w.y = cvtpk(v0[2], v0[3]); w.z = cvtpk(v1[0], v1[1]); w.w = cvtpk(v1[2], v1[3]);
                    *(u32x4*)(rowp + bj * HALF) = w; } }
    }
};
struct EpiInProj {
    static constexpr bool PERM = true;
    bf16_t* cq; bf16_t* ckv; float* ssq; bf16_t* qn; bf16_t* kv6; bf16_t* kmla; float* gates;
    const float* cosA; const float* sinA; const float* cosN; const float* sinN;
    __device__ __forceinline__ void operator()(const f32x4 (&acc)[2][2][4][2], const Unit& u, int wr, int wc, int fr, int fq) const {
        const int row0 = u.pm * BM + wr * 64 + fr, pn = u.pn;
#pragma unroll
        for (int ai = 0; ai < 2; ++ai)
#pragma unroll
            for (int m = 0; m < 4; ++m) {
                const size_t t = (size_t)(row0 + ai * HALF + m * 16);
                if (pn <= 2) {
                    float ss = 0.f;
#pragma unroll
                    for (int bj = 0; bj < 2; ++bj) { const f32x4 v0 = acc[ai][bj][m][0], v1 = acc[ai][bj][m][1];
                        ss += v0[0] * v0[0] + v0[1] * v0[1] + v0[2] * v0[2] + v0[3] * v0[3] + v1[0] * v1[0] + v1[1] * v1[1] + v1[2] * v1[2] + v1[3] * v1[3];
                        u32x4 w; w.x = cvtpk(v0[0], v0[1]); w.y = cvtpk(v0[2], v0[3]); w.z = cvtpk(v1[0], v1[1]); w.w = cvtpk(v1[2], v1[3]);
                        bf16_t* d = pn < 2 ? cq + t * 512 + pn * 256 + bj * HALF + wc * 32 + 8 * fq : ckv + t * 256 + bj * HALF + wc * 32 + 8 * fq;
                        *(u32x4*)d = w; }
                    ss += __shfl_xor(ss, 16); ss += __shfl_xor(ss, 32);
                    if (fq == 0) ssq[t * 16 + (pn < 2 ? pn * 4 + wc : 8 + wc)] = ss;
                } else if (pn <= 12) {
#pragma unroll
                    for (int bj = 0; bj < 2; ++bj) { const int blk = (pn - 3) * 2 + bj; const f32x4 v0 = acc[ai][bj][m][0], v1 = acc[ai][bj][m][1];
                        const bool rope = (blk < 8) || ((((blk - 8) >> 1) & 1) == 0);
                        bf16_t* d = blk < 8 ? qn + (t * 8 + blk) * 128 : kv6 + (size_t)((blk - 8) >> 1) * KV6_STRIDE + t * 256 + ((blk - 8) & 1) * 128;
                        if (rope && wc == 0) {
                            const f32x4 c = *(const f32x4*)(cosN + t * 16 + 4 * fq), sn = *(const f32x4*)(sinN + t * 16 + 4 * fq);
                            const f32x4 o1 = v0 * c - v1 * sn, o2 = v1 * c + v0 * sn;
                            *(u32x2*)(d + 4 * fq) = u32x2{cvtpk(o1[0], o1[1]), cvtpk(o1[2], o1[3])};
                            *(u32x2*)(d + 16 + 4 * fq) = u32x2{cvtpk(o2[0], o2[1]), cvtpk(o2[2], o2[3])};
                        } else {
                            u32x4 w; w.x = cvtpk(v0[0], v0[1]); w.y = cvtpk(v0[2], v0[3]); w.z = cvtpk(v1[0], v1[1]); w.w = cvtpk(v1[2], v1[3]);
                            *(u32x4*)(d + wc * 32 + 8 * fq) = w; }
                    }
                } else {
                    const f32x4 v0 = acc[ai][0][m][0], v1 = acc[ai][0][m][1];
                    if (wc < 2) {
                        const int f = (wc * 4 + fq) * 4;
                        const f32x4 c = *(const f32x4*)(cosA + t * 32 + f), sn = *(const f32x4*)(sinA + t * 32 + f);
                        const f32x4 o1 = v0 * c - v1 * sn, o2 = v1 * c + v0 * sn;
                        const u32x2 w1 = u32x2{cvtpk(o1[0], o1[1]), cvtpk(o1[2], o1[3])}, w2 = u32x2{cvtpk(o2[0], o2[1]), cvtpk(o2[2], o2[3])};
#pragma unroll
                        for (int h = 0; h < 8; ++h) { bf16_t* d = kmla + (t * 8 + h) * 192 + 128; *(u32x2*)(d + f) = w1; *(u32x2*)(d + 32 + f) = w2; }
                    } else if (wc == 2 && fq < 3) {
                        float* d = gates + t * 24 + 8 * fq;
                        f32x4 g0, g1;
#pragma unroll
                        for (int e = 0; e < 4; ++e) { g0[e] = 1.f / (1.f + __expf(-v0[e])); g1[e] = 1.f / (1.f + __expf(-v1[e])); }
                        *(f32x4*)d = g0; *(f32x4*)(d + 4) = g1;
                    }
                }
                asm volatile("" ::: "memory");
            }
    }
};
struct EpiBf16S {
    static constexpr bool PERM = true;
    bf16_t* O; int ldc; const float* ssq;
    __device__ __forceinline__ void operator()(const f32x4 (&acc)[2][2][4][2], const Unit& u, int wr, int wc, int fr, int fq) const {
        const int row0 = u.pm * BM + wr * 64 + fr, col0 = u.pn * BM + wc * 32 + 8 * fq;
#pragma unroll
        for (int ai = 0; ai < 2; ++ai)
#pragma unroll
            for (int m = 0; m < 4; ++m) { const size_t t = (size_t)(row0 + ai * HALF + m * 16);
                const f32x4 sa = *(const f32x4*)(ssq + t * 16), sb = *(const f32x4*)(ssq + t * 16 + 4);
                const float inv = rsqrtf((((sa[0] + sa[1]) + (sa[2] + sa[3])) + ((sb[0] + sb[1]) + (sb[2] + sb[3]))) * (1.f / 512.f) + 1e-6f);
                bf16_t* rowp = O + t * ldc + col0;
#pragma unroll
                for (int bj = 0; bj < 2; ++bj) { const f32x4 v0 = acc[ai][bj][m][0] * inv, v1 = acc[ai][bj][m][1] * inv;
                    u32x4 w; w.x = cvtpk(v0[0], v0[1]); w.y = cvtpk(v0[2], v0[3]); w.z = cvtpk(v1[0], v1[1]); w.w = cvtpk(v1[2], v1[3]);
                    *(u32x4*)(rowp + bj * HALF) = w; }
                asm volatile("" ::: "memory"); }
    }
};
struct EpiKV {
    static constexpr bool PERM = true;
    bf16_t* Kd; bf16_t* Vd; const float* ssq;
    __device__ __forceinline__ void operator()(const f32x4 (&acc)[2][2][4][2], const Unit& u, int wr, int wc, int fr, int fq) const {
        const int row0 = u.pm * BM + wr * 64 + fr, c0 = wc * 32 + 8 * fq, h = u.pn;
#pragma unroll
        for (int ai = 0; ai < 2; ++ai)
#pragma unroll
            for (int m = 0; m < 4; ++m) { const size_t t = (size_t)(row0 + ai * HALF + m * 16);
                const f32x4 sq = *(const f32x4*)(ssq + t * 16 + 8);
                const float inv = rsqrtf((sq[0] + sq[1] + sq[2] + sq[3]) * (1.f / 256.f) + 1e-6f);
#pragma unroll
                for (int bj = 0; bj < 2; ++bj) { const f32x4 v0 = acc[ai][bj][m][0] * inv, v1 = acc[ai][bj][m][1] * inv;
                    u32x4 w; w.x = cvtpk(v0[0], v0[1]); w.y = cvtpk(v0[2], v0[3]); w.z = cvtpk(v1[0], v1[1]); w.w = cvtpk(v1[2], v1[3]);
                    bf16_t* d = bj == 0 ? Kd + (t * 8 + h) * 192 + c0 : Vd + (t * 8 + h) * 128 + c0;
                    *(u32x4*)d = w; }
                asm volatile("" ::: "memory"); }
    }
};
template <class Epi, class Sched>
__device__ __forceinline__ void gemm_phase(PG8_LAS unsigned char* lds, const Gemm g, const Sched& S, const Epi& E) {
    const int tid = TID(), wid = __builtin_amdgcn_readfirstlane(tid >> 6), lane = tid & 63, wr = wid >> 2, wc = wid & 3, fr = lane & 15, fq = lane >> 4;
    const int K = g.K, nt = K / BK;
    unsigned voffA[2], voffB[2];
#pragma unroll
    for (int i = 0; i < 2; ++i) { int R, C; stage_rc(tid * 16 + i * 8192, R, C); const int Rb = Epi::PERM ? ((R & ~31) + perm32(R & 31)) : R;
        voffA[i] = (unsigned)(R * K + C) * 2u; voffB[i] = (unsigned)(Rb * K + C) * 2u; }
    const size_t kstep = (size_t)(BK * 2);
    const size_t hstep = (size_t)HALF * K * 2;
    const size_t tstep = 2 * hstep;
    const unsigned ldsw = (unsigned)wid * 1024u;
    const int aoff = lds_byte(wr * 64 + fr, fq * 8), boff = lds_byte(wc * 32 + fr, fq * 8);
#define PG8_SA(b, h) (((b) * 2 + (h)) * HTB)
#define PG8_SB(b, h) ((4 + (b) * 2 + (h)) * HTB)
#define PG8_STAGE(bufoff, gbase, voff) do { _Pragma("unroll") for (int _i = 0; _i < 2; ++_i) \
        __builtin_amdgcn_global_load_lds((const unsigned*)((const char*)(gbase) + (voff)[_i]), (PG8_LAS unsigned*)(lds + (bufoff) + ldsw + _i * 8192), 16, 0, 0); } while (0)
#define PG8_LDA(dst, b, h) do { _Pragma("unroll") for (int m = 0; m < 4; ++m) _Pragma("unroll") for (int k = 0; k < 2; ++k) dst[m][k] = *(const PG8_LAS bf16x8*)(lds + PG8_SA(b, h) + aoff + m * 2048 + k * 1024); } while (0)
#define PG8_LDB(dst, b, h) do { _Pragma("unroll") for (int n = 0; n < 2; ++n) _Pragma("unroll") for (int k = 0; k < 2; ++k) dst[n][k] = *(const PG8_LAS bf16x8*)(lds + PG8_SB(b, h) + boff + n * 2048 + k * 1024); } while (0)
#define PG8_MMA(ai, bj, At, Bt) do { __builtin_amdgcn_s_setprio(1); _Pragma("unroll") for (int m = 0; m < 4; ++m) _Pragma("unroll") for (int n = 0; n < 2; ++n) _Pragma("unroll") for (int k = 0; k < 2; ++k) \
        acc[ai][bj][m][n] = __builtin_amdgcn_mfma_f32_16x16x32_bf16(Bt[n][k], At[m][k], acc[ai][bj][m][n], 0, 0, 0); __builtin_amdgcn_s_setprio(0); } while (0)
#define PG8_WAIT_V(n) asm volatile("s_waitcnt vmcnt(" #n ")" ::: "memory")
#define PG8_WAIT_L(n) asm volatile("s_waitcnt lgkmcnt(" #n ")" ::: "memory")
#define PG8_BAR __builtin_amdgcn_s_barrier()
#define PG8_SCHED __builtin_amdgcn_sched_barrier(0)
    Unit cur, nxt; int ui = 0;
    if (!S.next(0, cur)) return;
    f32x4 acc[2][2][4][2];
#pragma unroll
    for (int a = 0; a < 2; ++a)
#pragma unroll
        for (int b = 0; b < 2; ++b)
#pragma unroll
            for (int m = 0; m < 4; ++m)
#pragma unroll
                for (int n = 0; n < 2; ++n) acc[a][b][m][n] = (f32x4){0.f, 0.f, 0.f, 0.f};
    bf16x8 At[4][2], B0[2][2], B1[2][2];
    const char* cA = (const char*)g.A + (size_t)cur.pm * tstep; const char* cB = (const char*)g.Bt + (size_t)cur.pn * tstep;
    S.a_ready(cur);
    PG8_STAGE(PG8_SB(0, 0), cB, voffB); PG8_STAGE(PG8_SA(0, 0), cA, voffA); PG8_STAGE(PG8_SB(0, 1), cB + hstep, voffB); PG8_STAGE(PG8_SA(0, 1), cA + hstep, voffA);
    if (wr == 1) PG8_BAR;
    PG8_WAIT_V(4); PG8_BAR;
    PG8_STAGE(PG8_SB(1, 0), cB + kstep, voffB); PG8_STAGE(PG8_SA(1, 0), cA + kstep, voffA); PG8_STAGE(PG8_SB(1, 1), cB + hstep + kstep, voffB);
    PG8_WAIT_V(6); PG8_BAR;
    for (;;) {
        const bool has_next = S.next(ui + 1, nxt);
        const char* nA = has_next ? (const char*)g.A + (size_t)nxt.pm * tstep : cA; const char* nB = has_next ? (const char*)g.Bt + (size_t)nxt.pn * tstep : cB;
        for (int t = 0; t < nt; t += 2) {
            const bool last = (t == nt - 2);
            const char* a1 = cA + (size_t)(t + 1) * kstep;
            const char* a2 = last ? nA : cA + (size_t)(t + 2) * kstep; const char* b2 = last ? nB : cB + (size_t)(t + 2) * kstep;
            const char* a3 = a2 + kstep; const char* b3 = b2 + kstep;
            if (last && has_next) S.a_ready(nxt);
            if constexpr (has_mid<Epi>::v) { if (t == nt / 2) E.mid(acc, cur, wr, wc, fr, fq); }
            PG8_LDB(B0, 0, 0); PG8_SCHED; PG8_LDA(At, 0, 0); PG8_STAGE(PG8_SA(1, 1), a1 + hstep, voffA);
            PG8_WAIT_L(8); PG8_BAR; PG8_WAIT_L(0); PG8_MMA(0, 0, At, B0); PG8_BAR; PG8_SCHED;
            PG8_LDB(B1, 0, 1); PG8_STAGE(PG8_SB(0, 0), b2, voffB);
            PG8_BAR; PG8_WAIT_L(0); PG8_MMA(0, 1, At, B1); PG8_BAR;
            PG8_LDA(At, 0, 1); PG8_STAGE(PG8_SA(0, 0), a2, voffA);
            PG8_BAR; PG8_WAIT_L(0); PG8_MMA(1, 0, At, B0); PG8_BAR; PG8_SCHED;
            PG8_STAGE(PG8_SB(0, 1), b2 + hstep, voffB);
            PG8_WAIT_V(6); PG8_BAR; PG8_MMA(1, 1, At, B1); PG8_BAR;
            PG8_LDB(B0, 1, 0); PG8_SCHED; PG8_LDA(At, 1, 0); PG8_STAGE(PG8_SA(0, 1), a2 + hstep, voffA);
            PG8_WAIT_L(8); PG8_BAR; PG8_WAIT_L(0); PG8_MMA(0, 0, At, B0); PG8_BAR; PG8_SCHED;
            PG8_LDB(B1, 1, 1); PG8_STAGE(PG8_SB(1, 0), b3, voffB);
            PG8_BAR; PG8_WAIT_L(0); PG8_MMA(0, 1, At, B1); PG8_BAR;
            PG8_LDA(At, 1, 1); PG8_STAGE(PG8_SA(1, 0), a3, voffA);
            PG8_BAR; PG8_WAIT_L(0); PG8_MMA(1, 0, At, B0); PG8_BAR; PG8_SCHED;
            PG8_STAGE(PG8_SB(1, 1), b3 + hstep, voffB);
            PG8_WAIT_V(6); PG8_BAR; PG8_MMA(1, 1, At, B1); PG8_BAR;
        }
        E(acc, cur, wr, wc, fr, fq); S.done(cur);
        if (!has_next) break;
#pragma unroll
        for (int a = 0; a < 2; ++a)
#pragma unroll
            for (int b = 0; b < 2; ++b)
#pragma unroll
                for (int m = 0; m < 4; ++m)
#pragma unroll
                    for (int n = 0; n < 2; ++n) acc[a][b][m][n] = (f32x4){0.f, 0.f, 0.f, 0.f};
        cur = nxt; cA = nA; cB = nB; ++ui;
    }
    PG8_WAIT_V(0);
    if (wr == 0) PG8_BAR;
    PG8_BAR;
#undef PG8_SA
#undef PG8_SB
#undef PG8_STAGE
#undef PG8_LDA
#undef PG8_LDB
#undef PG8_MMA
#undef PG8_WAIT_V
#undef PG8_WAIT_L
#undef PG8_BAR
#undef PG8_SCHED
}
}

__device__ __forceinline__ int inproj_src(const int n) {
    if (n < 768) return n;
    if (n < 3328) { const int np = n - 768, blk = np >> 7; int d = np & 127;
        const bool rope = (blk < 8) || ((((blk - 8) >> 1) & 1) == 0);
        if (rope && d < 32) { const int q = d >> 3, e = d & 7; d = (e < 4) ? (4 * q + e) : (16 + 4 * q + (e - 4)); }
        return C_QN + blk * 128 + d; }
    if (n < 3392) { const int i = n - 3328, q = i >> 3, e = i & 7; return C_KR + ((e < 4) ? (4 * q + e) : (32 + 4 * q + (e - 4))); }
    if (n < DIN) return n;
    return -1;
}
template <bool INPROJ>
__device__ __forceinline__ void tr_tile(const float* __restrict__ src, const int K, const int N, bf16* __restrict__ dst, const int k0, const int n0,
                                        const float* __restrict__ gain, const float* __restrict__ gain2, char* lds) {
    float* tl = (float*)lds;
    const int tid = TID();
    f32x4 v[8];
#pragma unroll
    for (int ps = 0; ps < 8; ++ps) { const int kr = (tid >> 6) + ps * 8, nc = (tid & 63) * 4, n = n0 + nc;
        const int sc = INPROJ ? inproj_src(n) : (n < N ? n : -1);
        v[ps] = sc >= 0 ? *reinterpret_cast<const f32x4*>(src + (long)(k0 + kr) * N + sc) : f32x4{0.f, 0.f, 0.f, 0.f}; }
#pragma unroll
    for (int ps = 0; ps < 8; ++ps) { const int kr = (tid >> 6) + ps * 8, nc = (tid & 63) * 4;
        if (gain) v[ps] = v[ps] * ((gain2 && k0 + kr >= 1024) ? gain2[k0 + kr - 1024] : gain[k0 + kr]);
#pragma unroll
        for (int e = 0; e < 4; ++e) tl[kr * 257 + nc + e] = v[ps][e]; }
    __syncthreads();
#pragma unroll
    for (int ps = 0; ps < 4; ++ps) { const int n = (tid >> 3) + ps * 64, kc = tid & 7; float x[8];
#pragma unroll
      for (int j = 0; j < 8; ++j) x[j] = tl[(kc * 8 + j) * 257 + n];
      u32x4 w = {cvtpk(x[0], x[1]), cvtpk(x[2], x[3]), cvtpk(x[4], x[5]), cvtpk(x[6], x[7])};
      *reinterpret_cast<u32x4*>(dst + (long)(n0 + n) * K + k0 + kc * 8) = w; }
    __syncthreads();
}
__device__ __forceinline__ void prologue_weights(const Params& p, char* lds, const int lsel, const int b0, const int nb) {
    bf16* wt = WS_PTR(bf16, WS_WT);
    constexpr int T_IN = 32 * 14, T_OUT = 32 * 8, T_UQ = 8 * 6, T_UKV = 4 * 8, T_XO = 8 * 8, T_L = T_IN + T_OUT + T_UQ + T_UKV + T_XO;
    if ((int)blockIdx.x < b0 || (int)blockIdx.x >= b0 + nb) return;
    for (int u = (int)blockIdx.x - b0; u < T_L; u += nb) {
        const int l = lsel; int r = u;
        const float* src; bf16* dst; int K, N, ntn; const float* gain = nullptr; const float* gain2 = nullptr;
        if (r < T_IN) { src = p.w_in + (long)l * DM * DIN; dst = wt + l * WT_LAYER + WT_IN; K = DM; N = DIN; ntn = 14;
            const int kt = r / ntn, nt = r - kt * ntn; tr_tile<true>(src, K, N, dst, kt * 64, nt * 256, nullptr, nullptr, lds); continue; }
        else if ((r -= T_IN) < T_OUT) { src = p.w_out + (long)l * DM * DM; dst = wt + l * WT_LAYER + WT_OUT; K = DM; N = DM; ntn = 8; gain = p.g_ya + l * 1024; gain2 = p.g_yb + l * 1024; }
        else if ((r -= T_OUT) < T_UQ) { src = p.w_uq + (long)l * 512 * 1536; dst = wt + l * WT_LAYER + WT_UQ; K = 512; N = 1536; ntn = 6; gain = p.g_cq + l * 512; }
        else if ((r -= T_UQ) < T_UKV) { src = p.w_ukv + (long)l * 256 * 2048; dst = wt + l * WT_LAYER + WT_UKV; K = 256; N = 2048; ntn = 8; gain = p.g_ckv + l * 256; }
        else { r -= T_UKV; src = p.w_xo + (long)l * 512 * DM; dst = wt + l * WT_LAYER + WT_XO; K = 512; N = DM; ntn = 8; }
        const int kt = r / ntn, nt = r - kt * ntn;
        tr_tile<false>(src, K, N, dst, kt * 64, nt * 256, gain, gain2, lds);
    }
}

typedef GC<256, 128, 4, 2> G256;
typedef GC<128, 128, 2, 4> G128;
typedef GC<128, 256, 2, 4> GMOE;

template <class C, class MK>
__device__ __forceinline__ void gemm_phase_plain(char* lds, const bf16* A, const long lda, const int M, const float* W, const int N, const int K,
                                                 const int u0, const int ustride, const MK& mk, const float* gk = nullptr) {
    const int ntn = (N + C::BN - 1) / C::BN, ntm = (M + C::BM - 1) / C::BM;
    for (int u = u0; u < ntm * ntn; u += ustride) {
        const int mt = u / ntn, nt = u - mt * ntn;
        ARowsPlain af{A, lda, mt * C::BM, M}; BPlain bf{W, (long)N, nt * C::BN, N, gk};
        gemm_tile<C>(lds, K / 64, af, bf, mk(mt * C::BM, nt * C::BN));
    }
}

__device__ __forceinline__ void phase_inproj(const Params& p, char* lds, const int l) {
    const int G = gridDim.x, bx = blockIdx.x;
    {
        pg8::Gemm g{WS_PTR(const pg8::bf16_t, WS_XN), WS_PTR(const pg8::bf16_t, WS_WT) + l * WT_LAYER + WT_IN, T, DINP, DM};
        pg8::StaticOrder so; so.init(T, DINP, G, bx);
        pg8::EpiInProj ep{WS_PTR(pg8::bf16_t, WS_CQN), WS_PTR(pg8::bf16_t, WS_CKVN), WS_PTR(float, WS_SSQ), WS_PTR(pg8::bf16_t, WS_QN), WS_PTR(pg8::bf16_t, WS_KV6),
                          WS_PTR(pg8::bf16_t, WS_KMLA), WS_PTR(float, WS_GATES), WS_PTR(const float, WS_COSA), WS_PTR(const float, WS_SINA),
                          WS_PTR(const float, WS_COSN), WS_PTR(const float, WS_SINN)};
        pg8::gemm_phase(( PG8_LAS unsigned char*)lds, g, so, ep);
    }
    if (l == 0) {
        bias1_finish(p);
        for (int ll = 0; ll < 2; ++ll) {
            bf16* kvx = WS_PTR(bf16, WS_KVX) + (long)ll * 1024 * 1024;
            for (int u = (bx + 64) % G; u < 64; u += G) {
                const int mt = u >> 3, nt = u & 7;
                ARowsPlain af{WS_PTR(const bf16, WS_MEMN), DM, mt * 128, 1024}; BPlain bf{p.w_xkv + (long)ll * DM * 1024, 1024, nt * 128, 1024, nullptr};
                hgemm1_tile(lds, DM / 64, af, bf, HEpiBf16{kvx, 1024, mt * 128, nt * 128, 1024, nullptr});
            }
        }
    }
}
struct ARowsCmpK {
    const bf16* base; int m0, kbase;
    __device__ __forceinline__ const bf16* row(int r) const { int R = m0 + r; R = R < CMP_ROWS ? R : CMP_ROWS - 1;
        const int bg = R / NCMP, c = R - bg * NCMP, b = bg >> 1, g = bg & 1; return base + ((long)(b * S + c * 16) * 2 + g) * 128; }
    __device__ __forceinline__ long koff(int k0) const { const int k = kbase + k0; return (long)(k >> 7) * 256 + (k & 127); }
};
__device__ __forceinline__ void phase_cmp1(const Params& p, char* lds, const int l, const int u0) {
    const int G = gridDim.x;
    for (int u = u0; u < 256; u += G) {
        const int which = u >> 7, ks = (u >> 5) & 3, mt = (u >> 2) & 7, nt = u & 3;
        ARowsCmpK af{WS_PTR(const bf16, WS_KV6) + which * KV6_STRIDE, mt * 128, ks * 1024};
        BPlain bf{(which ? p.w_cv1 : p.w_ck1) + (long)l * 4096 * 512 + (long)ks * 1024 * 512, 512, nt * 128, 512, nullptr};
        HEpiF32 ef{WS_PTR(float, WS_CMP1P) + ((long)(ks * 2 + which) * 1024) * 512, 512, mt * 128, nt * 128, 1024};
        hgemm1_tile(lds, 16, af, bf, ef);
    }
}
__device__ __forceinline__ void phase_upproj(const Params& p, char* lds, const int l) {
    const int G = gridDim.x, bx = blockIdx.x;
    {
        pg8::Gemm g{WS_PTR(const pg8::bf16_t, WS_CQN), WS_PTR(const pg8::bf16_t, WS_WT) + l * WT_LAYER + WT_UQ, T, 1536, 512};
        pg8::StaticOrder so; so.init(T, 1536, G, bx);
        pg8::EpiBf16S ep{WS_PTR(pg8::bf16_t, WS_QMLA), 1536, WS_PTR(const float, WS_SSQ)};
        pg8::gemm_phase((PG8_LAS unsigned char*)lds, g, so, ep);
    }
    {
        pg8::Gemm g{WS_PTR(const pg8::bf16_t, WS_CKVN), WS_PTR(const pg8::bf16_t, WS_WT) + l * WT_LAYER + WT_UKV, T, 2048, 256};
        pg8::StaticOrder so; so.init(T, 2048, G, (bx + 192) % G);
        pg8::EpiKV ep{WS_PTR(pg8::bf16_t, WS_KMLA), WS_PTR(pg8::bf16_t, WS_VMLA), WS_PTR(const float, WS_SSQ)};
        pg8::gemm_phase((PG8_LAS unsigned char*)lds, g, so, ep);
    }
    phase_cmp1(p, lds, l, bx);
}
__device__ __forceinline__ void phase_cmp2(const Params& p, char* lds, const int l) {
    const int tid = TID(); float* hid = (float*)lds;
    for (int u = blockIdx.x; u < 2 * 127; u += gridDim.x) {
        const int which = u / 127, r0 = (u - which * 127) * 8;
        const float* bias = WS_PTR(const float, WS_BIAS1) + (l * 2 + which) * 512;
        __syncthreads();
#pragma unroll
        for (int i = 0; i < 8; ++i) { const int e = tid + i * 512, r = e >> 9, c = e & 511; float a = bias[c];
#pragma unroll
            for (int ks = 0; ks < 4; ++ks) a += WS_PTR(const float, WS_CMP1P)[((long)(ks * 2 + which) * 1024 + r0 + r) * 512 + c];
            hid[e] = gelu_tanh(a); }
        __syncthreads();
        const int col = tid & 127, rp = tid >> 7; const float* w2 = (which ? p.w_cv2 : p.w_ck2) + (long)l * 512 * 128 + col;
        float a0 = 0.f, a1 = 0.f;
#pragma unroll 8
        for (int k = 0; k < 512; ++k) { const float w = w2[k * 128]; a0 += hid[(rp * 2) * 512 + k] * w; a1 += hid[(rp * 2 + 1) * 512 + k] * w; }
        bf16* outp = WS_PTR(bf16, WS_KCMP) + (long)which * 8 * 128 * 128;
#pragma unroll
        for (int q = 0; q < 2; ++q) { const int R = r0 + rp * 2 + q; if (R < CMP_ROWS) { const int bg = R / NCMP, c = R - bg * NCMP;
            outp[((long)bg * 128 + c) * 128 + col] = __float2bfloat16(q ? a1 : a0); } }
    }
}
__device__ __forceinline__ void phase_attn_mla(const Params& p, char* lds, const int l, const int dup) {
    const int tid = TID();
    volatile int* slot = (volatile int*)(lds + L_MISC);
    int* qc = WS_PTR(int, CTL_Q) + l * 2 + dup * 4;
    for (;;) {
        __syncthreads();
        if (tid == 0) slot[0] = atomicAdd(qc, 1);
        __syncthreads();
        const int qi = slot[0]; if (qi >= 256) break;
        mla_unit(p, lds, (qi & 31) >> 3, qi & 7, 7 - (qi >> 5));
    }
}
__device__ __forceinline__ void phase_attn_nsa(const Params& p, char* lds, const int l, const int dup) {
    const int tid = TID();
    {
        for (int i = tid; i < 2 * 64 * 32; i += NTHR) { const int tt = i >> 11, k = (i >> 5) & 63, n = i & 31, c = tt * 64 + k;
            const bool ov = (c * 16 <= n * 64 + 63) && (c * 16 + 31 >= n * 64);
            const int kk = (k & ~0xC) | ((k & 4) << 1) | ((k & 8) >> 1);
            *(unsigned short*)(lds + L_OV + tt * 4096 + (kk >> 3) * 512 + ((kk & 7) * 32 + n) * 2) = ov ? 0x3F80 : 0; }
    }
    volatile int* slot = (volatile int*)(lds + L_MISC);
    int* qc = WS_PTR(int, CTL_Q) + l * 2 + dup * 4;
    for (;;) {
        __syncthreads();
        if (tid == 0) slot[0] = atomicAdd(qc + 1, 1);
        __syncthreads();
        const int qi = slot[0]; if (qi >= 256) break;
        nsa_unit(p, lds, (qi & 7) >> 1, qi & 1, 31 - (qi >> 3));
    }
}
__device__ __forceinline__ void phase_xattn(const Params& p, char* lds, const int l) {
    for (int u = blockIdx.x; u < 128; u += gridDim.x) xattn_unit(p, lds, l, u >> 5, (u >> 3) & 3, u & 7);
}
__device__ __forceinline__ void phase_router(const Params& p, char* lds, const int l) {
    for (int u = blockIdx.x; u < T / 128; u += gridDim.x) {
        row_inv_to_lds(lds, WS_PTR(const float, WS_HSSQ), u * 128);
        ARowsPlain af{WS_PTR(const bf16, WS_HB), DM, u * 128, T};
        BRouter bf{p.w_grp + (long)l * DM * 8, p.w_exp + (long)l * DM * 64, nullptr};
        HEpiRouter ef{lds, p.b_grp + l * 8, p.b_exp + l * 64, WS_PTR(int, CTL_CNT) + l * 64, WS_PTR(int, WS_TOKE), WS_PTR(int, WS_TOKR),
                     WS_PTR(int, WS_ELIST), WS_PTR(float, WS_EGATE), WS_PTR(float, WS_EINV), u * 128};
        hgemm1_tile(lds, DM / 64, af, bf, ef);
    }
}
__device__ __forceinline__ int moe_find(const int* toff, const int tile) { int e = 0;
#pragma unroll 1
    for (int s = 32; s > 0; s >>= 1) if (toff[e + s] <= tile) e += s; return e; }
template <int NCH, class F>
__device__ __forceinline__ void moe_xcd_queues(char* lds, int* heads, const int ngrp, const F& body) {
    volatile int* slot = (volatile int*)(lds + L_MISC);
    const int my = (int)(xb_xcc_id() & 7u), tid = TID();
    for (int sft = 0; sft < 8; ++sft) {
        const int q = (my + sft) & 7, nq = q < ngrp ? (ngrp - q + 7) >> 3 : 0;
        for (;;) {
            __syncthreads();
            if (tid == 0) slot[0] = atomicAdd(heads + q * 16, 1);
            __syncthreads();
            const int i = slot[0]; if (i >= nq * NCH) break;
            body(q + 8 * (i / NCH), i % NCH);
        }
    }
}
template <int VAR> __device__ __forceinline__ void phase_moe1(const Params& p, char* lds, const int l, const int dup) {
    moe_prefix(p, lds, l);
    const int* offs = (const int*)(lds + L_PFX); const int* toff = offs + 65; const int* cnt = WS_PTR(const int, CTL_CNT) + l * 64;
    moe_xcd_queues<8>(lds, WS_PTR(int, CTL_XQ) + ((l * 2 + 0) * 2 + dup) * 128, toff[64], [&](const int grp, const int ch) {
        const int e = moe_find(toff, grp); const int r0 = (grp - toff[e]) * 384, c = cnt[e];
        const int rows = (c - r0) < 384 ? (c - r0) : 384;
        AVGather af{WS_PTR(const bf16, WS_HB), WS_PTR(const int, WS_ELIST) + e * ECAP, r0, c};
        BVGateUp bf{p.w_e1 + ((long)l * NEXP + e) * DM * 512, p.w_e3 + ((long)l * NEXP + e) * DM * 512, ch * 64, nullptr};
        EVMoe1 ef{(VAR ? WS_PTR(bf16, WS_PROJ) : WS_PTR(bf16, WS_HBUF)) + (long)(offs[e] + r0) * 512, WS_PTR(const float, WS_EINV) + e * ECAP + r0, ch * 64, rows};
        { const int nb_ = (rows + 127) >> 7;
          if (VAR == 0) { if (nb_ >= 3) hgemm_tile<3>(lds, DM / 64, af, bf, ef); else if (nb_ == 2) hgemm3s_tile<2>(lds, DM / 64, af, bf, ef); else hgemm3s_tile<1>(lds, DM / 64, af, bf, ef); }
          else vgemm_tile_n<VAR, 0>(lds, DM / 64, nb_, af, bf, ef); }
    });
}
template <int VAR> __device__ __forceinline__ void phase_moe2(const Params& p, char* lds, const int l, const int dup) {
    moe_prefix(p, lds, l);
    const int* offs = (const int*)(lds + L_PFX); const int* toff = offs + 65; const int* cnt = WS_PTR(const int, CTL_CNT) + l * 64;
    moe_xcd_queues<16>(lds, WS_PTR(int, CTL_XQ) + ((l * 2 + 1) * 2 + dup) * 128, toff[64], [&](const int grp, const int ch) {
        const int e = moe_find(toff, grp); const int r0 = (grp - toff[e]) * 384, c = cnt[e];
        const int rows = (c - r0) < 384 ? (c - r0) : 384;
        AVPlain af{WS_PTR(const bf16, WS_HBUF) + (long)(offs[e] + r0) * 512, 512, rows};
        BVPlain bf{p.w_e2 + ((long)l * NEXP + e) * 512 * DM, DM, ch * 128, nullptr};
        EVMoe2 ef{(VAR ? WS_PTR(bf16, WS_PROJ) : WS_PTR(bf16, WS_YBUF)) + (long)(offs[e] + r0) * DM, WS_PTR(const float, WS_EGATE) + e * ECAP + r0, ch * 128, rows};
        { const int nb_ = (rows + 127) >> 7;
          if (VAR == 0) { if (nb_ >= 3) hgemm_tile<3>(lds, 512 / 64, af, bf, ef); else if (nb_ == 2) hgemm3s_tile<2>(lds, 512 / 64, af, bf, ef); else hgemm3s_tile<1>(lds, 512 / 64, af, bf, ef); }
          else vgemm_tile_n<VAR, 0>(lds, 512 / 64, nb_, af, bf, ef); }
    });
}

#if defined(__HIP_DEVICE_COMPILE__)
#define PHASE_LOADP() const Params __attribute__((address_space(4)))* pp_ = (const Params __attribute__((address_space(4)))*)__builtin_amdgcn_kernarg_segment_ptr(); \
    asm volatile("" : "+s"(pp_)); Params p; PFIELDS(PHASE_LDF) p.ph_lo = 0; p.ph_hi = 0;
#else
#define PHASE_LOADP() Params p{};
#endif
#define PHASE_LDF(f) p.f = pp_->f;
#define PHASE_FN(name) static __device__ __forceinline__ void name(char* lds, const int l, const int dup) { (void)l; (void)lds; (void)dup; PHASE_LOADP()
#define PHASE_END }
PHASE_FN(ph_norm0)
    float* h = WS_PTR(float, WS_H);
    if (l == 0) {
        norm_rows<false>(p, p.x, T, p.g_mix, WS_PTR(bf16, WS_XN), nullptr, nullptr, nullptr);
        norm_rows<false>(p, p.mem, 1024, p.g_mem, WS_PTR(bf16, WS_MEMN), nullptr, nullptr, nullptr);
        prologue_misc(p, lds);
        prologue_weights(p, lds, 0, 0, gridDim.x);
    } else {
        moe_prefix(p, lds, l - 1);
        norm_rows<true>(p, h, T, p.g_mix + l * DM, WS_PTR(bf16, WS_XN), nullptr, dup ? nullptr : h, (const int*)(lds + L_PFX));
    }
PHASE_END
PHASE_FN(ph_inproj) phase_inproj(p, lds, l); PHASE_END
PHASE_FN(ph_post) phase_post(p, l); PHASE_END
PHASE_FN(ph_upproj) phase_upproj(p, lds, l); PHASE_END
PHASE_FN(ph_cmp2) phase_cmp2(p, lds, l); PHASE_END
PHASE_FN(ph_attn) phase_attn_mla(p, lds, l, dup); phase_attn_nsa(p, lds, l, dup); PHASE_END
PHASE_FN(ph_combine) phase_combine(p, l); PHASE_END
PHASE_FN(ph_outproj)
    float* h = WS_PTR(float, WS_H); const float* res = l == 0 ? p.x : h;
    pg8::Gemm g{WS_PTR(const pg8::bf16_t, WS_Y), WS_PTR(const pg8::bf16_t, WS_WT) + l * WT_LAYER + WT_OUT, T, DM, DM};
    pg8::StaticOrder so; so.init(T, DM, gridDim.x, blockIdx.x);
    {
        pg8::Unit u0; const int tid = TID();
        if (so.next(0, u0) && tid < 256) { const float* ys = WS_PTR(const float, WS_YSSQ) + (long)(u0.pm * 256 + tid) * 16;
            const f32x4 a0 = *(const f32x4*)ys, a1 = *(const f32x4*)(ys + 4), b0 = *(const f32x4*)(ys + 8), b1 = *(const f32x4*)(ys + 12);
            const float ia = rsqrtf((((a0[0] + a0[1]) + (a0[2] + a0[3])) + ((a1[0] + a1[1]) + (a1[2] + a1[3]))) * (1.f / 1024.f) + 1e-6f);
            const float ib = rsqrtf((((b0[0] + b0[1]) + (b0[2] + b0[3])) + ((b1[0] + b1[1]) + (b1[2] + b1[3]))) * (1.f / 1024.f) + 1e-6f);
            ((float*)(lds + L_YSC))[tid] = ia / ib; ((float*)(lds + L_YSC))[256 + tid] = ib; }
        __syncthreads();
    }
    pg8::EpiResH ep{dup ? WS_PTR(float, WS_PROJ) : h, res, dup ? WS_PTR(pg8::bf16_t, WS_XN) : WS_PTR(pg8::bf16_t, WS_HB), WS_PTR(float, WS_HSSQ), (const float*)(lds + L_YSC), p.g_x + l * DM, DM};
    pg8::gemm_phase((PG8_LAS unsigned char*)lds, g, so, ep);
PHASE_END
PHASE_FN(ph_normx) norm_rows<false>(p, WS_PTR(const float, WS_H), T, p.g_x + l * DM, WS_PTR(bf16, WS_XN), nullptr, nullptr, nullptr); PHASE_END
PHASE_FN(ph_qx)
    bf16* qx = WS_PTR(bf16, WS_QX);
    for (int u = blockIdx.x; u < (T / 128) * 4; u += gridDim.x) {
        const int mt = u >> 2, nt = u & 3;
        row_inv_to_lds(lds, WS_PTR(const float, WS_HSSQ), mt * 128);
        ARowsPlain af{WS_PTR(const bf16, WS_HB), DM, mt * 128, T}; BPlain bf{p.w_xq + (long)l * DM * 512, 512, nt * 128, 512, nullptr};
        hgemm1_tile(lds, DM / 64, af, bf, HEpiBf16{qx, 512, mt * 128, nt * 128, T, (const float*)(lds + L_RINV)});
    }
PHASE_END
PHASE_FN(ph_xattn) phase_xattn(p, lds, l); PHASE_END
PHASE_FN(ph_xo)
    float* h = WS_PTR(float, WS_H);
    pg8::Gemm g{WS_PTR(const pg8::bf16_t, WS_OX), WS_PTR(const pg8::bf16_t, WS_WT) + l * WT_LAYER + WT_XO, T, DM, 512};
    pg8::StaticOrder so; so.init(T, DM, gridDim.x, blockIdx.x);
    pg8::EpiResH ep{dup ? WS_PTR(float, WS_PROJ) : h, h, dup ? WS_PTR(pg8::bf16_t, WS_XN) : WS_PTR(pg8::bf16_t, WS_HB), WS_PTR(float, WS_HSSQ), nullptr, p.g_ffn + l * DM, DM};
    pg8::gemm_phase((PG8_LAS unsigned char*)lds, g, so, ep);
PHASE_END
PHASE_FN(ph_normf) norm_rows<false>(p, WS_PTR(const float, WS_H), T, p.g_ffn + l * DM, WS_PTR(bf16, WS_XN), nullptr, nullptr, nullptr); PHASE_END
PHASE_FN(ph_router) if (!dup) { phase_router(p, lds, l); if (l == 0) prologue_weights(p, lds, 1, 64, gridDim.x - 64); } PHASE_END
PHASE_FN(ph_moe1) if (dup && PROBE_VAR) phase_moe1<PROBE_VAR>(p, lds, l, dup); else phase_moe1<0>(p, lds, l, dup); PHASE_END
PHASE_FN(ph_moe2) if (dup && PROBE_VAR) phase_moe2<PROBE_VAR>(p, lds, l, dup); else phase_moe2<0>(p, lds, l, dup); PHASE_END
PHASE_FN(ph_final)
    moe_prefix(p, lds, DEPTH - 1);
    norm_rows<true>(p, WS_PTR(const float, WS_H), T, p.g_final, nullptr, p.out, nullptr, (const int*)(lds + L_PFX));
PHASE_END

constexpr int NPH_LAYER = 12;
constexpr int NPH = DEPTH * NPH_LAYER + 1;
#if defined(__HIP_DEVICE_COMPILE__)
#define KARG(f) ({ const Params __attribute__((address_space(4)))* q_ = (const Params __attribute__((address_space(4)))*)__builtin_amdgcn_kernarg_segment_ptr(); asm volatile("" : "+s"(q_)); q_->f; })
#else
#define KARG(f) (p.f)
#endif
__global__ void __launch_bounds__(NTHR, 2) fwd(const Params p) {
    extern __shared__ __attribute__((aligned(16))) char lds[];
    {
        const int tid = TID();
        if (tid < 64) ((volatile unsigned*)(lds + L_MISC))[tid] = 0u;
        __syncthreads();
        if (KARG(ph_hi) - KARG(ph_lo) > 1) (void)xcd_barrier_post((unsigned*)(KARG(ws) + WS_CTL), (volatile LAS unsigned*)(lds + L_MISC + 16));
    }
    int ph = 0;
#define BARRIER() do { XcdBarrier bar_; bar_.bar = (unsigned*)(KARG(ws) + WS_CTL); bar_.x = xb_xcc_id(); bar_.st = (volatile LAS unsigned*)(lds + L_MISC + 16); \
        xcd_barrier(bar_); if (PROBE_BAR2) xcd_barrier(bar_); } while (0)
#define RUN(k, fn, l_) do { if (KARG(ph_lo) <= ph && ph < KARG(ph_hi)) { fn(lds, (l_), 0); if ((PROBE_MASK >> (k)) & 1) { BARRIER(); fn(lds, (l_), 1); } if (ph + 1 < KARG(ph_hi)) BARRIER(); } ++ph; } while (0)
#define LAYER(l) do { \
    RUN(0, ph_norm0, l); \
    RUN(1, ph_inproj, l); \
    RUN(3, ph_upproj, l); \
    RUN(4, ph_cmp2, l); \
    RUN(5, ph_attn, l); \
    RUN(8, ph_outproj, l); \
    RUN(10, ph_qx, l); \
    RUN(11, ph_xattn, l); \
    RUN(12, ph_xo, l); \
    RUN(14, ph_router, l); \
    RUN(15, ph_moe1, l); \
    RUN(16, ph_moe2, l); \
    } while (0)
    static_assert(DEPTH == 2, "layer program written out twice");
    LAYER(0); LAYER(1);
#undef LAYER
    RUN(17, ph_final, 0);
#undef RUN
#undef BARRIER
}

extern "C" void kernel_launch(void* const* d_in, const int* in_sizes, int n_in, void* d_out, int out_size, void* d_ws, size_t ws_size, hipStream_t stream) {
    static int grid = 0;
    if (grid == 0) {
        if (n_in != 32 || in_sizes[0] != T * DM || out_size != T * DM || ws_size < WS_END) {
            fprintf(stderr, "kernel_launch: shape mismatch n_in %d in0 %d out %d ws %zu (need %zu)\n", n_in, n_in > 0 ? in_sizes[0] : -1, out_size, ws_size, (size_t)WS_END); grid = -1; return; }
        int dev = 0, cus = 0, per_cu = 0;
        if (hipGetDevice(&dev) != hipSuccess || hipDeviceGetAttribute(&cus, hipDeviceAttributeMultiprocessorCount, dev) != hipSuccess) { grid = -1; return; }
        if (hipFuncSetAttribute((const void*)fwd, hipFuncAttributeMaxDynamicSharedMemorySize, LDS_BYTES) != hipSuccess) { fprintf(stderr, "kernel_launch: hipFuncSetAttribute failed\n"); grid = -1; return; }
        if (hipOccupancyMaxActiveBlocksPerMultiprocessor(&per_cu, (const void*)fwd, NTHR, LDS_BYTES) != hipSuccess || per_cu < 1)
            fprintf(stderr, "kernel_launch: occupancy query reports %d\n", per_cu);
        (void)hipGetLastError();
        if (cus < 256) { fprintf(stderr, "kernel_launch: built for a 256-CU device (got %d)\n", cus); grid = -1; return; }
        grid = cus;
    }
    if (grid < 0) return;
    (void)hipMemsetAsync((char*)d_ws + WS_CTL, 0, CTL_BYTES, stream);
    Params p{};
    const float* const* f = (const float* const*)d_in;
    p.x = f[0]; p.mem = f[1]; p.positions = (const int*)d_in[2];
    p.g_mem = f[3]; p.g_final = f[4]; p.g_mix = f[5]; p.w_in = f[6]; p.g_cq = f[7]; p.w_uq = f[8]; p.g_ckv = f[9]; p.w_ukv = f[10];
    p.pe_k = f[11]; p.pe_v = f[12]; p.w_ck1 = f[13]; p.w_ck2 = f[14]; p.w_cv1 = f[15]; p.w_cv2 = f[16]; p.g_ya = f[17]; p.g_yb = f[18];
    p.w_out = f[19]; p.g_x = f[20]; p.w_xq = f[21]; p.w_xkv = f[22]; p.w_xo = f[23]; p.g_ffn = f[24]; p.w_grp = f[25]; p.b_grp = f[26];
    p.w_exp = f[27]; p.b_exp = f[28]; p.w_e1 = f[29]; p.w_e3 = f[30]; p.w_e2 = f[31];
    p.out = (float*)d_out; p.ws = (unsigned char*)d_ws;
#if MK_FUSED
    p.ph_lo = 0; p.ph_hi = NPH;
    hipLaunchKernelGGL(fwd, dim3(grid), dim3(NTHR), LDS_BYTES, stream, p);
#else
    for (int ph = 0; ph < NPH; ++ph) { p.ph_lo = ph; p.ph_hi = ph + 1; hipLaunchKernelGGL(fwd, dim3(grid), dim3(NTHR), LDS_BYTES, stream, p); }
#endif
    const hipError_t le = hipPeekAtLastError();
    if (le != hipSuccess) fprintf(stderr, "kernel_launch: launch failed: %s\n", hipGetErrorName(le));
}
```

```cpp
#include <hip/hip_runtime.h>
#include <hip/hip_bf16.h>
#include <stdint.h>
#include <stdio.h>
#include <math.h>
#include <stddef.h>

typedef __hip_bfloat16 bf16;
typedef short bf16x8 __attribute__((ext_vector_type(8)));
typedef short s16x4 __attribute__((ext_vector_type(4)));
typedef float f32x16 __attribute__((ext_vector_type(16)));
typedef float f32x4 __attribute__((ext_vector_type(4)));
typedef float f32x2 __attribute__((ext_vector_type(2)));
typedef unsigned u32x4 __attribute__((ext_vector_type(4)));
typedef unsigned u32x2 __attribute__((ext_vector_type(2)));

#ifndef MK_FUSED
#define MK_FUSED 1
#endif
#ifndef ATT_PIPE2
#define ATT_PIPE2 1
#endif
#ifndef PROBE_MASK
#define PROBE_MASK 0
#endif
#ifndef PROBE_VAR
#define PROBE_VAR 0
#endif
#ifndef PROBE_BAR2
#define PROBE_BAR2 0
#endif

constexpr int NB = 4, S = 2048, T = NB * S, DM = 2048, DEPTH = 2;
constexpr int DIN = 3416, DINP = 3584;
constexpr int C_CQ = 0, C_CKV = 512, C_KR = 768, C_QN = 832, C_KC = 1856, C_VC = 2112, C_KS = 2368, C_VS = 2624, C_KW = 2880, C_VW = 3136, C_GT = 3392;
constexpr int NCMP = 127, CMP_ROWS = NB * 2 * NCMP;
constexpr int NEXP = 64, ECAP = 8192, NASG = T * 2;
constexpr int NTHR = 512;

constexpr size_t al256(size_t x) { return (x + 255) / 256 * 256; }
constexpr size_t WS_CTL = 0;
constexpr size_t CTL_BYTES = 32768;
constexpr size_t CTL_CNT = 16384;
constexpr size_t CTL_Q = 16384 + 1024;
constexpr size_t CTL_XQ = 16384 + 2048;
constexpr size_t WS_H = WS_CTL + CTL_BYTES;
constexpr size_t WS_XN = WS_H + (size_t)T * DM * 4;
constexpr size_t WS_PROJ = WS_XN + (size_t)T * DM * 2;
constexpr size_t WS_CQN = WS_PROJ + (size_t)T * DINP * 4;
constexpr size_t WS_CKVN = WS_CQN + (size_t)T * 512 * 2;
constexpr size_t WS_QMLA = WS_CKVN + (size_t)T * 256 * 2;
constexpr size_t WS_KMLA = WS_QMLA + (size_t)T * 1536 * 2;
constexpr size_t WS_VMLA = WS_KMLA + (size_t)T * 1536 * 2;
constexpr size_t WS_QN = WS_VMLA + (size_t)T * 1024 * 2;
constexpr size_t WS_KV6 = WS_QN + (size_t)T * 1024 * 2;
constexpr size_t KV6_STRIDE = (size_t)T * 256;
constexpr size_t WS_GATES = WS_KV6 + 6 * KV6_STRIDE * 2;
constexpr size_t WS_COSA = WS_GATES + (size_t)T * 24 * 4;
constexpr size_t WS_SINA = WS_COSA + (size_t)T * 32 * 4;
constexpr size_t WS_COSN = WS_SINA + (size_t)T * 32 * 4;
constexpr size_t WS_SINN = WS_COSN + (size_t)T * 16 * 4;
constexpr size_t WS_MEMN = WS_SINN + (size_t)T * 16 * 4;
constexpr size_t WS_KVX = WS_MEMN + (size_t)1024 * 2048 * 2;
constexpr size_t WS_BIAS1 = WS_KVX + (size_t)2 * 1024 * 1024 * 2;
constexpr size_t WS_HID = WS_BIAS1 + 2 * 2 * 512 * 4;
constexpr size_t WS_KCMP = WS_HID + (size_t)2 * 1024 * 512 * 2;
constexpr size_t WS_YMLA = WS_KCMP + (size_t)2 * 8 * 128 * 128 * 2;
constexpr size_t WS_YNSA = WS_YMLA + (size_t)T * 1024 * 2;
constexpr size_t WS_Y = WS_YNSA + (size_t)T * 1024 * 4;
constexpr size_t WS_QX = WS_Y + (size_t)T * 2048 * 2;
constexpr size_t WS_OX = WS_QX + (size_t)T * 512 * 2;
constexpr size_t WS_TOKE = WS_OX + (size_t)T * 512 * 2;
constexpr size_t WS_TOKR = WS_TOKE + (size_t)T * 2 * 4;
constexpr size_t WS_ELIST = WS_TOKR + (size_t)T * 2 * 4;
constexpr size_t WS_EGATE = WS_ELIST + (size_t)NEXP * ECAP * 4;
constexpr size_t WS_HBUF = WS_EGATE + (size_t)NEXP * ECAP * 4;
constexpr size_t WS_YBUF = WS_HBUF + (size_t)NASG * 512 * 2;
constexpr size_t WS_WT = WS_YBUF + (size_t)NASG * 2048 * 2;
constexpr size_t WT_IN = 0, WT_OUT = WT_IN + (size_t)DINP * DM, WT_UQ = WT_OUT + (size_t)DM * DM, WT_UKV = WT_UQ + (size_t)1536 * 512,
                 WT_XO = WT_UKV + (size_t)2048 * 256, WT_LAYER = WT_XO + (size_t)DM * 512;
constexpr size_t WS_SSQ = WS_WT + 2 * WT_LAYER * 2;
constexpr size_t WS_HSSQ = WS_SSQ + (size_t)T * 16 * 4;
constexpr size_t WS_YSSQ = WS_HSSQ + (size_t)T * 32 * 4;
constexpr size_t WS_HB = WS_YSSQ + (size_t)T * 16 * 4;
constexpr size_t WS_EINV = WS_HB + (size_t)T * DM * 2;
constexpr size_t WS_B1PART = WS_EINV + (size_t)NEXP * ECAP * 4;
constexpr size_t WS_CMP1P = WS_B1PART + 4 * 16 * 512 * 4;
constexpr size_t WS_END = WS_CMP1P + (size_t)4 * 2 * 1024 * 512 * 4;

constexpr int LDS_BYTES = 131072 + 4096;
constexpr int L_YSC = 131072 + 2048;
constexpr int L_RINV = 131072 + 1280;
constexpr int SHM_V = 64 * 128 * 2;
constexpr int SHM_KMAX = 64 * 192 * 2;
constexpr int L_V = 0, L_K = 2 * SHM_V, L_WS = L_K + 2 * SHM_KMAX;
constexpr int L_OV = L_WS + 8 * 512;
constexpr int L_IMP = L_OV + 8192;
constexpr int L_SELM = L_IMP + 33792;
constexpr int L_TL = L_SELM + 256;
constexpr int L_MISC = 131072;
constexpr int L_PFX = L_MISC + 256;
static_assert(L_TL + 160 <= 131072 && L_PFX + 1024 <= LDS_BYTES, "lds");

#define XB_TMO      128
#define XB_XCNT(j)  (256  + 64 * (j))
#define XB_XSUB(j)  (1280 + 64 * (j))
#define XB_XGEN(j)  (2304 + 64 * (j))
#define XB_TOP      3328
#define XB_TOPGEN   3392
#define XCD_BAR_WORDS 3456
#define XB_SPIN_CAP (1u << 22)
#define LAS __attribute__((address_space(3)))
__device__ __forceinline__ unsigned xb_ld(unsigned* p)              { return __hip_atomic_load(p, __ATOMIC_RELAXED, __HIP_MEMORY_SCOPE_AGENT); }
__device__ __forceinline__ unsigned xb_add(unsigned* p, unsigned v) { return __hip_atomic_fetch_add(p, v, __ATOMIC_RELAXED, __HIP_MEMORY_SCOPE_AGENT); }
__device__ __forceinline__ unsigned xb_xcc_id() { return (unsigned)__builtin_amdgcn_s_getreg((3 << 11) | 20) & 0xFu; }
#define XB_SPIN(cond, bar) do { unsigned _sp = 0; while (cond) { __builtin_amdgcn_s_sleep(1); \
    if ((++_sp & 255u) == 0u) { if (xb_ld(&(bar)[XB_TMO])) break; if (_sp > XB_SPIN_CAP) { atomicAdd(&(bar)[XB_TMO], 1u); break; } } } } while (0)
struct XcdBarrier { unsigned* bar; unsigned x; volatile LAS unsigned* st; };
__device__ __forceinline__ XcdBarrier xcd_barrier_post(unsigned* bar, volatile LAS unsigned* st) {
    XcdBarrier b; b.bar = bar; b.x = xb_xcc_id(); b.st = st;
    if (threadIdx.x == 0) (void)xb_add(&bar[XB_XCNT(b.x)], 1u);
    return b;
}
__device__ __forceinline__ void xcd_barrier_complete(unsigned* bar, unsigned x, unsigned& nloc, unsigned& nx) {
    const unsigned G = gridDim.x * gridDim.y * gridDim.z;
    unsigned sum, cnt, mine, sp = 0u;
    for (;;) {
        sum = 0u; cnt = 0u; mine = 0u;
#pragma unroll
        for (unsigned j = 0; j < 16; ++j) { const unsigned c = xb_ld(&bar[XB_XCNT(j)]); sum += c; cnt += (c > 0u) ? 1u : 0u; mine = (j == x) ? c : mine; }
        if (sum == G) break;
        __builtin_amdgcn_s_sleep(1);
        if ((++sp & 255u) == 0u) { if (xb_ld(&bar[XB_TMO])) break; if (sp > XB_SPIN_CAP) { atomicAdd(&bar[XB_TMO], 1u); break; } }
    }
    nloc = mine > 0u ? mine : 1u; nx = cnt > 0u ? cnt : 1u;
}
__device__ __forceinline__ void xcd_barrier(const XcdBarrier& b) {
    asm volatile("s_waitcnt vmcnt(0)" ::: "memory");
    __syncthreads();
    if (threadIdx.x == 0) {
        unsigned* bar = b.bar;
        __builtin_amdgcn_s_waitcnt(0);
        unsigned nloc = b.st[0], nx = b.st[1];
        if (nloc == 0u) { xcd_barrier_complete(bar, b.x, nloc, nx); b.st[0] = nloc; b.st[1] = nx; }
        const unsigned old = xb_add(&bar[XB_XSUB(b.x)], 1u);
        const unsigned gen = old / nloc;
        if (old + 1u == (gen + 1u) * nloc) {
            __builtin_amdgcn_fence(__ATOMIC_RELEASE, "agent");
            asm volatile("s_waitcnt vmcnt(0)" ::: "memory");
            const unsigned og = xb_add(&bar[XB_TOP], 1u);
            const unsigned tg = og / nx;
            if (og + 1u == (tg + 1u) * nx) xb_add(&bar[XB_TOPGEN], 1u);
            else XB_SPIN(xb_ld(&bar[XB_TOPGEN]) == tg, bar);
            __builtin_amdgcn_fence(__ATOMIC_ACQUIRE, "agent");
            xb_add(&bar[XB_XGEN(b.x)], 1u);
            asm volatile("s_waitcnt vmcnt(0)" ::: "memory");
        } else {
            XB_SPIN(xb_ld(&bar[XB_XGEN(b.x)]) == gen, bar);
            __builtin_amdgcn_fence(__ATOMIC_ACQUIRE, "agent");
            asm volatile("s_waitcnt vmcnt(0)" ::: "memory");
        }
    }
    __syncthreads();
}

struct Params {
    const float *x, *mem; const int* positions;
    const float *g_mem, *g_final, *g_mix, *w_in, *g_cq, *w_uq, *g_ckv, *w_ukv, *pe_k, *pe_v, *w_ck1, *w_ck2, *w_cv1, *w_cv2,
                *g_ya, *g_yb, *w_out, *g_x, *w_xq, *w_xkv, *w_xo, *g_ffn, *w_grp, *b_grp, *w_exp, *b_exp, *w_e1, *w_e3, *w_e2;
    float* out; unsigned char* ws;
    int ph_lo, ph_hi;
};
#define PFIELDS(X) X(x) X(mem) X(positions) X(g_mem) X(g_final) X(g_mix) X(w_in) X(g_cq) X(w_uq) X(g_ckv) X(w_ukv) X(pe_k) X(pe_v) X(w_ck1) X(w_ck2) \
    X(w_cv1) X(w_cv2) X(g_ya) X(g_yb) X(w_out) X(g_x) X(w_xq) X(w_xkv) X(w_xo) X(g_ffn) X(w_grp) X(b_grp) X(w_exp) X(b_exp) X(w_e1) X(w_e3) X(w_e2) X(out) X(ws)
__device__ __forceinline__ int TID() { int t = threadIdx.x; asm volatile("" : "+v"(t)); return t; }
#define SBAR() __builtin_amdgcn_sched_barrier(0)
__device__ __forceinline__ unsigned cvtpk(float lo, float hi) {
    unsigned r; asm volatile("v_cvt_pk_bf16_f32 %0, %1, %2" : "=v"(r) : "v"(lo), "v"(hi)); return r;
}
__device__ __forceinline__ float bf2f(unsigned short v) { return __uint_as_float(((unsigned)v) << 16); }
__device__ __forceinline__ float bflo(unsigned w) { return __uint_as_float(w << 16); }
__device__ __forceinline__ float bfhi(unsigned w) { return __uint_as_float(w & 0xffff0000u); }
__device__ __forceinline__ float swap1(float v) { return __int_as_float(__builtin_amdgcn_update_dpp(0, __float_as_int(v), 0xB1, 0xF, 0xF, false)); }
__device__ __forceinline__ float wave_sum(float v) {
#pragma unroll
    for (int o = 32; o > 0; o >>= 1) v += __shfl_xor(v, o);
    return v;
}
__device__ __forceinline__ void st_bf16_pair(bf16* p_even_aligned_base, int col, float v, int lane) {
    const float vn = swap1(v);
    if ((lane & 1) == 0) *(unsigned*)(p_even_aligned_base + col) = cvtpk(v, vn);
}

template <int BM_, int BN_, int WM_, int WN_> struct GC {
    static constexpr int BM = BM_, BN = BN_, WM = WM_, WN = WN_, TM = BM / WM, TN = BN / WN, MI = TM / 16, NJ = TN / 16;
    static constexpr int NA = BM / 64;
    static constexpr int NQ = BN / 4;
    static constexpr int KG = NTHR / NQ;
    static constexpr int KR = 64 / KG;
    static constexpr int A_BYTES = BM * 128, B_BYTES = BN * 128, STAGE = A_BYTES + B_BYTES;
    static_assert(WM * WN == 8 && (KR == 4 || KR == 8) && 2 * STAGE <= LDS_BYTES - 1024, "cfg");
};

template <class C, class AF, class BF, class EF>
__device__ __forceinline__ void gemm_tile(char* lds, const int nk, const AF& af, const BF& bf, const EF& ef) {
    const int tid = TID(), lane = tid & 63, wid = tid >> 6;
    const int wm = wid / C::WN, wn = wid % C::WN;
    const int ac = tid & 7, ar0 = tid >> 3;
    const bf16* aptr[C::NA];
#pragma unroll
    for (int i = 0; i < C::NA; ++i) aptr[i] = af.row(ar0 + 64 * i) + ac * 8;
    const int alds0 = ar0 * 128 + ((ac ^ ((ar0 >> 1) & 7)) << 4);
    const int n4 = tid % C::NQ, kg = tid / C::NQ;
    long ldb = 0; const float* bptr = bf.col(n4 * 4, ldb); const float* gk = bf.gk;
    int blds[4];
#pragma unroll
    for (int e = 0; e < 4; ++e) { const int n = n4 * 4 + e; const int sw = (n >> 1) & 7;
        blds[e] = C::A_BYTES + n * 128 + (C::KR == 8 ? ((kg ^ sw) << 4) : ((((kg >> 1) ^ sw) << 4) + (kg & 1) * 8)); }
    bf16x8 areg[C::NA]; f32x4 breg[C::KR]; float greg[C::KR];
    auto gload = [&](int kt) {
        const long ko = af.koff(kt * 64);
#pragma unroll
        for (int i = 0; i < C::NA; ++i) areg[i] = *reinterpret_cast<const bf16x8*>(aptr[i] + ko);
        if (bptr) {
#pragma unroll
            for (int kk = 0; kk < C::KR; ++kk) { breg[kk] = *reinterpret_cast<const f32x4*>(bptr + (long)(kt * 64 + kg * C::KR + kk) * ldb);
                if (gk) greg[kk] = gk[kt * 64 + kg * C::KR + kk]; }
        } else {
#pragma unroll
            for (int kk = 0; kk < C::KR; ++kk) breg[kk] = f32x4{0.f, 0.f, 0.f, 0.f};
        }
    };
    auto lstore = [&](char* buf) {
#pragma unroll
        for (int i = 0; i < C::NA; ++i) *reinterpret_cast<bf16x8*>(buf + alds0 + i * 64 * 128) = areg[i];
        if (gk && bptr) {
#pragma unroll
            for (int kk = 0; kk < C::KR; ++kk) breg[kk] = breg[kk] * greg[kk]; }
#pragma unroll
        for (int e = 0; e < 4; ++e) {
            if constexpr (C::KR == 8) {
                u32x4 w = {cvtpk(breg[0][e], breg[1][e]), cvtpk(breg[2][e], breg[3][e]), cvtpk(breg[4][e], breg[5][e]), cvtpk(breg[6][e], breg[7][e])};
                *reinterpret_cast<u32x4*>(buf + blds[e]) = w;
            } else {
                u32x2 w = {cvtpk(breg[0][e], breg[1][e]), cvtpk(breg[2][e], breg[3][e])};
                *reinterpret_cast<u32x2*>(buf + blds[e]) = w;
            }
        }
    };
    f32x4 acc[C::MI][C::NJ];
#pragma unroll
    for (int i = 0; i < C::MI; ++i)
#pragma unroll
        for (int j = 0; j < C::NJ; ++j) acc[i][j] = f32x4{0.f, 0.f, 0.f, 0.f};
    const int fsw = (lane >> 1) & 7, fq = lane >> 4;
    const int foff0 = (lane & 15) * 128 + (((0 + fq) ^ fsw) << 4), foff1 = (lane & 15) * 128 + (((4 + fq) ^ fsw) << 4);
    gload(0); lstore(lds); __syncthreads();
    for (int kt = 0; kt < nk; ++kt) {
        char* cur = lds + (kt & 1) * C::STAGE; char* nxt = lds + ((kt + 1) & 1) * C::STAGE;
        if (kt + 1 < nk) gload(kt + 1);
#pragma unroll
        for (int ks = 0; ks < 2; ++ks) {
            const int fo = ks ? foff1 : foff0;
            bf16x8 a[C::MI], b[C::NJ];
#pragma unroll
            for (int i = 0; i < C::MI; ++i) a[i] = *reinterpret_cast<const bf16x8*>(cur + (wm * C::TM + i * 16) * 128 + fo);
#pragma unroll
            for (int j = 0; j < C::NJ; ++j) b[j] = *reinterpret_cast<const bf16x8*>(cur + C::A_BYTES + (wn * C::TN + j * 16) * 128 + fo);
#pragma unroll
            for (int i = 0; i < C::MI; ++i)
#pragma unroll
                for (int j = 0; j < C::NJ; ++j) acc[i][j] = __builtin_amdgcn_mfma_f32_16x16x32_bf16(a[i], b[j], acc[i][j], 0, 0, 0);
        }
        if (kt + 1 < nk) lstore(nxt);
        __syncthreads();
    }
    ef.template run<C>(acc, wm, wn, lane);
}

__device__ __forceinline__ void row_inv_to_lds(char* lds, const float* hssq, const int m0) {
    const int tid = TID();
    if (tid < 128) { const float* q = hssq + (long)(m0 + tid) * 32; float ss = 0.f;
#pragma unroll
        for (int i = 0; i < 8; ++i) { const f32x4 v = *reinterpret_cast<const f32x4*>(q + i * 4); ss += (v[0] + v[1]) + (v[2] + v[3]); }
        ((float*)(lds + L_RINV))[tid] = rsqrtf(ss * (1.f / DM) + 1e-6f); }
}
struct ARowsPlain {
    const bf16* base; long lda; int m0, mmax;
    __device__ __forceinline__ const bf16* row(int r) const { int R = m0 + r; R = R < mmax ? R : mmax - 1; return base + (long)R * lda; }
    __device__ __forceinline__ long koff(int k0) const { return k0; }
};
struct ARowsCmp {
    const bf16* base; int m0;
    __device__ __forceinline__ const bf16* row(int r) const { int R = m0 + r; R = R < CMP_ROWS ? R : CMP_ROWS - 1;
        const int bg = R / NCMP, c = R - bg * NCMP, b = bg >> 1, g = bg & 1; return base + ((long)(b * S + c * 16) * 2 + g) * 128; }
    __device__ __forceinline__ long koff(int k0) const { return (long)(k0 >> 7) * 256 + (k0 & 127); }
};
struct ARowsGather {
    const bf16* base; const int* list; int r0, cnt;
    __device__ __forceinline__ const bf16* row(int r) const { int R = r0 + r; R = R < cnt ? R : cnt - 1; return base + (long)list[R] * DM; }
    __device__ __forceinline__ long koff(int k0) const { return k0; }
};
struct BPlain { const float* W; long ld; int n0, N; const float* gk;
    __device__ __forceinline__ const float* col(int c, long& ldo) const { ldo = ld; return (n0 + c < N) ? W + n0 + c : nullptr; } };
struct BRouter { const float* Wg; const float* We; const float* gk;
    __device__ __forceinline__ const float* col(int c, long& ldo) const {
        if (c < 8) { ldo = 8; return Wg + c; } if (c < 72) { ldo = 64; return We + (c - 8); } ldo = 8; return Wg; } };
struct BGateUp { const float* W1; const float* W3; int n0; const float* gk;
    __device__ __forceinline__ const float* col(int c, long& ldo) const { ldo = 512; const int wn = c >> 6, w = c & 63;
        const long d = (w & 32) ? (long)(W3 - W1) : 0L; return W1 + d + n0 + wn * 32 + (w & 31); } };

#define EPI_LOOP_BEGIN  _Pragma("unroll") for (int i = 0; i < C::MI; ++i) { _Pragma("unroll") for (int r = 0; r < 4; ++r) { \
        const int trow = wm * C::TM + i * 16 + (lane >> 4) * 4 + r; (void)trow;
#define EPI_LOOP_END }}

struct EpiF32 {
    float* Cc; const float* Rr; long ldc; int m0, n0, mmax;
    template <class C> __device__ __forceinline__ void run(f32x4 (&acc)[C::MI][C::NJ], int wm, int wn, int lane) const {
        EPI_LOOP_BEGIN
            const int R = m0 + trow;
            if (R < mmax) {
#pragma unroll
                for (int j = 0; j < C::NJ; ++j) { const long o = (long)R * ldc + n0 + wn * C::TN + j * 16 + (lane & 15);
                    float v = acc[i][j][r]; if (Rr) v += Rr[o]; Cc[o] = v; }
            }
        EPI_LOOP_END
    }
};
struct EpiBf16 {
    bf16* Cc; long ldc; int m0, n0, mmax; const float* rinv;
    template <class C> __device__ __forceinline__ void run(f32x4 (&acc)[C::MI][C::NJ], int wm, int wn, int lane) const {
        EPI_LOOP_BEGIN
            const int R = m0 + trow; const bool ok = R < mmax; const float ri = rinv ? rinv[trow] : 1.f;
#pragma unroll
            for (int j = 0; j < C::NJ; ++j) { const float v = acc[i][j][r] * ri; const float vn = swap1(v);
                if (ok && !(lane & 1)) *(unsigned*)(Cc + (long)R * ldc + n0 + wn * C::TN + j * 16 + (lane & 15)) = cvtpk(v, vn); }
        EPI_LOOP_END
    }
};
struct EpiQup {
    bf16* q; const float* cosA; const float* sinA; int m0, n0;
    template <class C> __device__ __forceinline__ void run(f32x4 (&acc)[C::MI][C::NJ], int wm, int wn, int lane) const {
        static_assert(C::TN == 64, "rope epilogue needs 64-col wave tiles");
        const int base = n0 + wn * 64, h = base / 192, db = base - h * 192;
        EPI_LOOP_BEGIN
            const int R = m0 + trow; bf16* qp = q + ((long)R * 8 + h) * 192 + db;
            if (db < 128) {
#pragma unroll
                for (int j = 0; j < 4; ++j) { const float v = acc[i][j][r]; const float vn = swap1(v);
                    if (!(lane & 1)) *(unsigned*)(qp + j * 16 + (lane & 15)) = cvtpk(v, vn); }
            } else {
#pragma unroll
                for (int j = 0; j < 2; ++j) { const int f = j * 16 + (lane & 15);
                    const float c = cosA[(long)R * 32 + f], s = sinA[(long)R * 32 + f];
                    const float x1 = acc[i][j][r], x2 = acc[i][j + 2][r];
                    const float o1 = x1 * c - x2 * s, o2 = x2 * c + x1 * s;
                    const float o1n = swap1(o1), o2n = swap1(o2);
                    if (!(lane & 1)) { *(unsigned*)(qp + f) = cvtpk(o1, o1n); *(unsigned*)(qp + 32 + f) = cvtpk(o2, o2n); } }
            }
        EPI_LOOP_END
    }
};
struct EpiKVup {
    bf16* k; bf16* v; int m0, n0;
    template <class C> __device__ __forceinline__ void run(f32x4 (&acc)[C::MI][C::NJ], int wm, int wn, int lane) const {
        static_assert(C::TN == 64, "64-col wave tiles");
        const int base = n0 + wn * 64, h = base >> 8, db = base & 255;
        EPI_LOOP_BEGIN
            const int R = m0 + trow;
            bf16* dp = (db < 128) ? k + ((long)R * 8 + h) * 192 + db : v + ((long)R * 8 + h) * 128 + (db - 128);
#pragma unroll
            for (int j = 0; j < 4; ++j) { const float x = acc[i][j][r]; const float xn = swap1(x);
                if (!(lane & 1)) *(unsigned*)(dp + j * 16 + (lane & 15)) = cvtpk(x, xn); }
        EPI_LOOP_END
    }
};
__device__ __forceinline__ float gelu_tanh(float x) {
    const float u = 0.7978845608028654f * (x + 0.044715f * x * x * x);
    const float e = __expf(2.f * u);
    const float t = 1.f - 2.f / (e + 1.f);
    return 0.5f * x * (1.f + t);
}
struct EpiCmp1 {
    bf16* hid; const float* bias; int m0, n0;
    template <class C> __device__ __forceinline__ void run(f32x4 (&acc)[C::MI][C::NJ], int wm, int wn, int lane) const {
        EPI_LOOP_BEGIN
            const int R = m0 + trow;
#pragma unroll
            for (int j = 0; j < C::NJ; ++j) { const int cg = n0 + wn * C::TN + j * 16 + (lane & 15);
                const float v = gelu_tanh(acc[i][j][r] + bias[cg]); const float vn = swap1(v);
                if (!(lane & 1)) *(unsigned*)(hid + (long)R * 512 + cg) = cvtpk(v, vn); }
        EPI_LOOP_END
    }
};
struct EpiCmp2 {
    bf16* outp; int m0;
    template <class C> __device__ __forceinline__ void run(f32x4 (&acc)[C::MI][C::NJ], int wm, int wn, int lane) const {
        EPI_LOOP_BEGIN
            const int R = m0 + trow; const bool ok = R < CMP_ROWS; const int bg = R / NCMP, c = R - bg * NCMP;
#pragma unroll
            for (int j = 0; j < C::NJ; ++j) { const float v = acc[i][j][r]; const float vn = swap1(v);
                if (ok && !(lane & 1)) *(unsigned*)(outp + ((long)bg * 128 + c) * 128 + wn * C::TN + j * 16 + (lane & 15)) = cvtpk(v, vn); }
        EPI_LOOP_END
    }
};
struct EpiMoe1 {
    bf16* hb; int n0, valid;
    template <class C> __device__ __forceinline__ void run(f32x4 (&acc)[C::MI][C::NJ], int wm, int wn, int lane) const {
        static_assert(C::TN == 64, "gate/up wave tile");
        EPI_LOOP_BEGIN
            const bool ok = trow < valid;
#pragma unroll
            for (int j = 0; j < 2; ++j) { const float g = acc[i][j][r], u = acc[i][j + 2][r];
                const float v = g / (1.f + __expf(-g)) * u; const float vn = swap1(v);
                if (ok && !(lane & 1)) *(unsigned*)(hb + (long)trow * 512 + n0 + wn * 32 + j * 16 + (lane & 15)) = cvtpk(v, vn); }
        EPI_LOOP_END
    }
};
struct EpiMoe2 {
    bf16* yb; const float* gate; int n0, valid;
    template <class C> __device__ __forceinline__ void run(f32x4 (&acc)[C::MI][C::NJ], int wm, int wn, int lane) const {
        EPI_LOOP_BEGIN
            const bool ok = trow < valid; const float gt = ok ? gate[trow] : 0.f;
#pragma unroll
            for (int j = 0; j < C::NJ; ++j) { const float v = acc[i][j][r] * gt; const float vn = swap1(v);
                if (ok && !(lane & 1)) *(unsigned*)(yb + (long)trow * DM + n0 + wn * C::TN + j * 16 + (lane & 15)) = cvtpk(v, vn); }
        EPI_LOOP_END
    }
};
struct EpiRouter {
    char* lds; const float* bg; const float* be; int* cnt; int* toke; int* tokr; int* elist; float* egate; float* einv; int m0;
    template <class C> __device__ __forceinline__ void run(f32x4 (&acc)[C::MI][C::NJ], int wm, int wn, int lane) const {
        float* lg = (float*)lds;
        EPI_LOOP_BEGIN
#pragma unroll
            for (int j = 0; j < C::NJ; ++j) { const int c = wn * C::TN + j * 16 + (lane & 15); if (c < 72) lg[trow * 73 + c] = acc[i][j][r] * ((const float*)(lds + L_RINV))[trow]; }
        EPI_LOOP_END
        __syncthreads();
        const int tid = TID();
        if (tid < 128) {
            const float* L = lg + tid * 73; const int t = m0 + tid;
            float gl[8]; float gm = -3e38f; int gi = 0;
#pragma unroll
            for (int g = 0; g < 8; ++g) { gl[g] = L[g] + bg[g]; if (gl[g] > gm) { gm = gl[g]; gi = g; } }
            float den = 0.f;
#pragma unroll
            for (int g = 0; g < 8; ++g) den += __expf(gl[g] - gm);
            const float ptop = 1.f / den;
            float v1 = -3e38f, v2 = -3e38f; int i1 = 0, i2 = 0;
#pragma unroll
            for (int e = 0; e < 8; ++e) { const float v = L[8 + gi * 8 + e] + be[gi * 8 + e];
                if (v > v1) { v2 = v1; i2 = i1; v1 = v; i1 = e; } else if (v > v2) { v2 = v; i2 = e; } }
            const float e2 = __expf(v2 - v1); const float w1 = 1.f / (1.f + e2), w2 = e2 / (1.f + e2);
            const int ex1 = gi * 8 + i1, ex2 = gi * 8 + i2;
            const int r1 = atomicAdd(&cnt[ex1], 1), r2 = atomicAdd(&cnt[ex2], 1);
            toke[t * 2] = ex1; toke[t * 2 + 1] = ex2; tokr[t * 2] = r1; tokr[t * 2 + 1] = r2;
            elist[ex1 * ECAP + r1] = t; elist[ex2 * ECAP + r2] = t;
            egate[ex1 * ECAP + r1] = ptop * w1; egate[ex2 * ECAP + r2] = ptop * w2;
            const float ri = ((const float*)(lds + L_RINV))[tid]; einv[ex1 * ECAP + r1] = ri; einv[ex2 * ECAP + r2] = ri;
        }
        __syncthreads();
    }
};
struct HEpiRouter {
    char* lds; const float* bg; const float* be; int* cnt; int* toke; int* tokr; int* elist; float* egate; float* einv; int m0;
    __device__ __forceinline__ void run(int, f32x4 (&acc)[2][4], int wm, int wn, int lane) const {
        float* lg = (float*)lds;
#pragma unroll
        for (int i = 0; i < 2; ++i)
#pragma unroll
            for (int r = 0; r < 4; ++r) { const int trow = wm * 32 + i * 16 + (lane >> 4) * 4 + r;
#pragma unroll
                for (int j = 0; j < 4; ++j) { const int c = wn * 64 + j * 16 + (lane & 15); if (c < 72) lg[trow * 73 + c] = acc[i][j][r] * ((const float*)(lds + L_RINV))[trow]; } }
        __syncthreads();
        const int tid = TID();
        if (tid < 128) {
            const float* L = lg + tid * 73; const int t = m0 + tid;
            float gl[8]; float gm = -3e38f; int gi = 0;
#pragma unroll
            for (int g = 0; g < 8; ++g) { gl[g] = L[g] + bg[g]; if (gl[g] > gm) { gm = gl[g]; gi = g; } }
            float den = 0.f;
#pragma unroll
            for (int g = 0; g < 8; ++g) den += __expf(gl[g] - gm);
            const float ptop = 1.f / den;
            float v1 = -3e38f, v2 = -3e38f; int i1 = 0, i2 = 0;
#pragma unroll
            for (int e = 0; e < 8; ++e) { const float v = L[8 + gi * 8 + e] + be[gi * 8 + e];
                if (v > v1) { v2 = v1; i2 = i1; v1 = v; i1 = e; } else if (v > v2) { v2 = v; i2 = e; } }
            const float e2 = __expf(v2 - v1); const float w1 = 1.f / (1.f + e2), w2 = e2 / (1.f + e2);
            const int ex1 = gi * 8 + i1, ex2 = gi * 8 + i2;
            const int r1 = atomicAdd(&cnt[ex1], 1), r2 = atomicAdd(&cnt[ex2], 1);
            toke[t * 2] = ex1; toke[t * 2 + 1] = ex2; tokr[t * 2] = r1; tokr[t * 2 + 1] = r2;
            elist[ex1 * ECAP + r1] = t; elist[ex2 * ECAP + r2] = t;
            egate[ex1 * ECAP + r1] = ptop * w1; egate[ex2 * ECAP + r2] = ptop * w2;
            const float ri = ((const float*)(lds + L_RINV))[tid]; einv[ex1 * ECAP + r1] = ri; einv[ex2 * ECAP + r2] = ri;
        }
        __syncthreads();
    }
};

constexpr float ATT_THR = 8.f;
__device__ __forceinline__ int v_st(int k, int c) { const int kk = (k & ~0xC) | ((k & 4) << 1) | ((k & 8) >> 1); return ((kk >> 3) * 4 + (c >> 5)) * 512 + ((kk & 7) * 32 + (c & 31)) * 2; }
__device__ __forceinline__ int v_rd_base(int lane) { return ((lane & 3) << 3) | (((lane >> 2) & 3) << 6) | (((lane >> 4) & 1) << 5) | (((lane >> 5) & 1) << 8); }
constexpr int v_rd_off(int d0, int ks, int half) { return d0 * 512 + ks * 4096 + half * 2048; }
__device__ __forceinline__ int crow(int r, int hi) { return (r & 3) + 8 * (r >> 2) + 4 * hi; }

__device__ __forceinline__ void mask_tile(f32x16& p0, f32x16& p1, int dq, unsigned W) {
    const float NEG = -__builtin_inff();
#pragma unroll
    for (int r = 0; r < 16; ++r) {
        const int c = (r & 3) + 8 * (r >> 2);
        if ((unsigned)(dq - c) >= W) p0[r] = NEG;
        if ((unsigned)(dq - c - 32) >= W) p1[r] = NEG;
    }
}
__device__ __forceinline__ void mask_all(f32x16& p0, f32x16& p1, bool keep) {
    const float NEG = -__builtin_inff();
#pragma unroll
    for (int r = 0; r < 16; ++r) { p0[r] = keep ? p0[r] : NEG; p1[r] = keep ? p1[r] : NEG; }
}
__device__ __forceinline__ void partialSM(f32x16& p0, f32x16& p1, float& m_reg, float& mn, float& alpha, const float C2, const float scl) {
    float pmax = p0[0];
#pragma unroll
    for (int r = 1; r < 16; ++r) pmax = fmaxf(pmax, p0[r]);
#pragma unroll
    for (int r = 0; r < 16; ++r) pmax = fmaxf(pmax, p1[r]);
    { auto rr = __builtin_amdgcn_permlane32_swap(__float_as_uint(pmax), __float_as_uint(pmax), false, false);
      pmax = fmaxf(__uint_as_float(rr[0]), __uint_as_float(rr[1])); }
    if (__builtin_expect(__all((pmax - m_reg) * scl <= ATT_THR), 1)) { mn = m_reg; alpha = 1.f; }
    else { mn = fmaxf(m_reg, pmax); alpha = __builtin_amdgcn_exp2f((m_reg - mn) * C2); m_reg = mn; }
    const float mnL = -mn * C2;
#pragma unroll
    for (int r = 0; r < 16; ++r) p0[r] = fmaf(p0[r], C2, mnL);
#pragma unroll
    for (int r = 0; r < 16; ++r) p1[r] = fmaf(p1[r], C2, mnL);
#pragma unroll
    for (int r = 0; r < 16; ++r) p0[r] = __builtin_amdgcn_exp2f(p0[r]);
}
__device__ __forceinline__ void finishSM(f32x16& p0, f32x16& p1, float alpha, float& l_reg, bf16x8& pa0, bf16x8& pa1, bf16x8& pa2, bf16x8& pa3) {
#pragma unroll
    for (int r = 0; r < 16; ++r) p1[r] = __builtin_amdgcn_exp2f(p1[r]);
    float ps = 0;
#pragma unroll
    for (int r = 0; r < 16; ++r) ps += p0[r];
#pragma unroll
    for (int r = 0; r < 16; ++r) ps += p1[r];
    { auto rr = __builtin_amdgcn_permlane32_swap(__float_as_uint(ps), __float_as_uint(ps), false, false);
      ps = __uint_as_float(rr[0]) + __uint_as_float(rr[1]); }
    l_reg = l_reg * alpha + ps;
#define PK4(P, B_, OUT) do { unsigned a0 = cvtpk(P[B_+0], P[B_+1]), a1 = cvtpk(P[B_+2], P[B_+3]);                          \
        unsigned b0 = cvtpk(P[B_+4], P[B_+5]), b1 = cvtpk(P[B_+6], P[B_+7]);                                             \
        auto r0 = __builtin_amdgcn_permlane32_swap(a0, b0, false, false); auto r1 = __builtin_amdgcn_permlane32_swap(a1, b1, false, false); \
        u32x4 w = {r0[0], r1[0], r0[1], r1[1]}; OUT = *reinterpret_cast<bf16x8*>(&w); } while (0)
    PK4(p0, 0, pa0); PK4(p0, 8, pa1); PK4(p1, 0, pa2); PK4(p1, 8, pa3);
#undef PK4
}
#define KSWZ(row, colB, RB) ((row) * (RB) + ((colB) ^ (((row) & 7) << 4)))
template <int DQK, int KB>
__device__ __forceinline__ void qkt(f32x16& p0, f32x16& p1, const char* K_lds, int r32, int hi, const bf16x8* qr) {
    constexpr int RB = DQK * 2, SHMK = 64 * RB;
    p0 = f32x16{}; p1 = f32x16{};
    const char* kb[4];
#pragma unroll
    for (int dd = 0; dd < 4; ++dd) kb[dd] = K_lds + KB * SHMK + KSWZ(r32, (dd * 16 + hi * 8) * 2, RB);
#pragma unroll
    for (int d0 = 0; d0 < DQK / 16; ++d0) { const char* a = kb[d0 & 3] + (d0 >> 2) * 128;
        bf16x8 b0 = *reinterpret_cast<const bf16x8*>(a);
        bf16x8 b1 = *reinterpret_cast<const bf16x8*>(a + 32 * RB);
        p0 = __builtin_amdgcn_mfma_f32_32x32x16_bf16(b0, qr[d0], p0, 0, 0, 0);
        p1 = __builtin_amdgcn_mfma_f32_32x32x16_bf16(b1, qr[d0], p1, 0, 0, 0); }
}
#define TRRD(dst, off) asm volatile("ds_read_b64_tr_b16 %0, %1 offset:%2" : "=&v"(dst) : "v"(vbx_), "i"(off) : "memory")
#define PV_BLK(ACC, VBX, b_, s0, s1) do { s16x4 l0, l1, l2, l3, h0, h1, h2, h3; const int vbx_ = (VBX);                                                 \
        TRRD(l0, (b_)); TRRD(h0, (b_) + (s0)); TRRD(l1, (b_) + (s1)); TRRD(h1, (b_) + (s1) + (s0)); TRRD(l2, (b_) + 2 * (s1)); TRRD(h2, (b_) + 2 * (s1) + (s0)); \
        TRRD(l3, (b_) + 3 * (s1)); TRRD(h3, (b_) + 3 * (s1) + (s0));                                                           \
        asm volatile("s_waitcnt lgkmcnt(0)" ::: "memory"); SBAR();                                                           \
        ACC = __builtin_amdgcn_mfma_f32_32x32x16_bf16(pa0, (bf16x8){l0[0], l0[1], l0[2], l0[3], h0[0], h0[1], h0[2], h0[3]}, ACC, 0, 0, 0);   \
        ACC = __builtin_amdgcn_mfma_f32_32x32x16_bf16(pa1, (bf16x8){l1[0], l1[1], l1[2], l1[3], h1[0], h1[1], h1[2], h1[3]}, ACC, 0, 0, 0);   \
        ACC = __builtin_amdgcn_mfma_f32_32x32x16_bf16(pa2, (bf16x8){l2[0], l2[1], l2[2], l2[3], h2[0], h2[1], h2[2], h2[3]}, ACC, 0, 0, 0);   \
        ACC = __builtin_amdgcn_mfma_f32_32x32x16_bf16(pa3, (bf16x8){l3[0], l3[1], l3[2], l3[3], h3[0], h3[1], h3[2], h3[3]}, ACC, 0, 0, 0); } while (0)
template <int VB, int PVM>
__device__ __forceinline__ void pv_tile(f32x16* o, int vb0, bf16x8 pa0, bf16x8 pa1, bf16x8 pa2, bf16x8 pa3) {
    if constexpr (PVM == 0 || PVM == 2) {
        PV_BLK(o[0], vb0, VB * SHM_V + 0 * 512, 2048, 4096);
        PV_BLK(o[1], vb0, VB * SHM_V + 1 * 512, 2048, 4096);
        PV_BLK(o[2], vb0, VB * SHM_V + 2 * 512, 2048, 4096);
        PV_BLK(o[3], vb0, VB * SHM_V + 3 * 512, 2048, 4096);
    }
    if constexpr (PVM == 1) { PV_BLK(o[0], vb0 + L_OV, VB * 4096, 512, 1024); }
    if constexpr (PVM == 2) { PV_BLK(o[4], vb0 + L_OV, VB * 4096, 512, 1024); }
}

template <int DQK, int MODE, int PVM, int PIPE = ATT_PIPE2>
__device__ __forceinline__ void flash_pass(const int tid, char* lds, const bf16x8* qr, const bf16* __restrict__ Kg, const long ldk,
                                           const bf16* __restrict__ Vg, const long ldv, const int NT, const int j_lo,
                                           const int epos, const int qlo_e, const unsigned W, const unsigned selm,
                                           const float C2, const float scl, f32x16* o, float& l_out) {
    constexpr int RB = DQK * 2, SHMK = 64 * RB;
    const int wid = __builtin_amdgcn_readfirstlane(tid >> 6), lane = tid & 63, r32 = lane & 31, hi = lane >> 5;
    char* V_lds = lds + L_V; char* K_lds = lds + L_K;
    float* wsp = (float*)(lds + L_WS) + wid * 128; float* al_l = wsp + 32;
    const volatile int* tl = (const volatile int*)(lds + L_TL);
    float m_reg = -1e30f, l_reg = 0.f;
#pragma unroll
    for (int d = 0; d < (PVM == 1 ? 1 : (PVM == 2 ? 5 : 4)); ++d) o[d] = f32x16{};
    const int sr = tid >> 4, sc = (tid & 15) * 8, vst0 = v_st(sr, sc), vst1 = v_st(32 + sr, sc), kws = KSWZ(sr, sc * 2, RB);
    const int sr3 = tid >> 3, sc3 = 128 + (tid & 7) * 8, kws3 = KSWZ(sr3, sc3 * 2, RB);
    const int vb0 = (int)(uintptr_t)V_lds + v_rd_base(lane);
    const int qm = epos - 4 * hi;
    bf16x8 st_v0, st_v1, st_k0, st_k1, st_k2;
#define KT(t) (MODE == 2 ? __builtin_amdgcn_readfirstlane(tl[(t)]) : (j_lo + (t)))
#define VMW() asm volatile("s_waitcnt vmcnt(0)" ::: "memory")
#define SLOAD(t) do { const long k0_ = (long)KT(t) * 64;                                                                        \
        if constexpr (PVM != 1) { st_v0 = *reinterpret_cast<const bf16x8*>(Vg + (k0_ + sr) * ldv + sc); st_v1 = *reinterpret_cast<const bf16x8*>(Vg + (k0_ + 32 + sr) * ldv + sc); } \
        st_k0 = *reinterpret_cast<const bf16x8*>(Kg + (k0_ + sr) * ldk + sc); st_k1 = *reinterpret_cast<const bf16x8*>(Kg + (k0_ + 32 + sr) * ldk + sc); \
        if constexpr (DQK == 192) st_k2 = *reinterpret_cast<const bf16x8*>(Kg + (k0_ + sr3) * ldk + sc3); } while (0)
#define SWRITE(bf) do { if constexpr (PVM != 1) { *(bf16x8*)(V_lds + (bf) * SHM_V + vst0) = st_v0; *(bf16x8*)(V_lds + (bf) * SHM_V + vst1) = st_v1; }    \
        *(bf16x8*)(K_lds + (bf) * SHMK + kws) = st_k0; *(bf16x8*)(K_lds + (bf) * SHMK + kws + 32 * RB) = st_k1;               \
        if constexpr (DQK == 192) *(bf16x8*)(K_lds + (bf) * SHMK + kws3) = st_k2; } while (0)
#define RESC(a) do { if (__any((a) < 1.f)) { if (hi == 0) al_l[r32] = (a); asm volatile("s_waitcnt lgkmcnt(0)" ::: "memory");    \
        _Pragma("unroll") for (int d_ = 0; d_ < (PVM == 1 ? 1 : (PVM == 2 ? 5 : 4)); ++d_) { _Pragma("unroll") for (int r = 0; r < 16; ++r) o[d_][r] *= al_l[crow(r, hi)]; } } } while (0)
#define MASKT(P0_, P1_, t) do { if (MODE != 0) { const int kt_ = KT(t); const int kb_ = kt_ * 64;                               \
        if (MODE == 1) { if (kb_ + 63 > qlo_e || kb_ <= qlo_e + 31 - (int)W) mask_tile(P0_, P1_, qm - kb_, W); }             \
        else { if (kb_ + 63 > qlo_e) mask_tile(P0_, P1_, qm - kb_, 0x40000000u); mask_all(P0_, P1_, ((selm >> kt_) & 1u) != 0u); } } } while (0)
    if constexpr (PIPE == 2) {
    f32x16 pA0, pA1, pB0, pB1; float mnA, mnB, alA, alB; bf16x8 pa0, pa1, pa2, pa3;
    __syncthreads();
    SLOAD(0); VMW(); SWRITE(0);
    if (NT > 1) SLOAD(1);
    __syncthreads();
    SBAR(); qkt<DQK, 0>(pA0, pA1, K_lds, r32, hi, qr);
    MASKT(pA0, pA1, 0); partialSM(pA0, pA1, m_reg, mnA, alA, C2, scl);
    if (NT > 1) { VMW(); SWRITE(1); }
    __syncthreads();
#define HALF_STEP(PX0, PX1, mnX, alX, PY0, PY1, alY, t, KB, VB, SB) do {                                                      \
        SBAR(); qkt<DQK, KB>(PX0, PX1, K_lds, r32, hi, qr);                                                                   \
        finishSM(PY0, PY1, alY, l_reg, pa0, pa1, pa2, pa3); SBAR();                                                           \
        if ((t) + 1 < NT) { SLOAD((t) + 1); SBAR(); }                                                                         \
        pv_tile<VB, PVM>(o, vb0, pa0, pa1, pa2, pa3); MASKT(PX0, PX1, (t)); partialSM(PX0, PX1, m_reg, mnX, alX, C2, scl);    \
        __syncthreads();                                                                                                      \
        if ((t) + 1 < NT) { VMW(); SWRITE(SB); }                                                                              \
        RESC(alX); __syncthreads(); } while (0)
    for (int t = 1; t + 1 < NT; t += 2) {
        HALF_STEP(pB0, pB1, mnB, alB, pA0, pA1, alA, t, 1, 0, 0);
        HALF_STEP(pA0, pA1, mnA, alA, pB0, pB1, alB, t + 1, 0, 1, 1);
    }
    const bool even = (NT & 1) == 0;
    if (even) { SBAR(); qkt<DQK, 1>(pB0, pB1, K_lds, r32, hi, qr); SBAR(); }
    finishSM(pA0, pA1, alA, l_reg, pa0, pa1, pa2, pa3); SBAR();
    pv_tile<0, PVM>(o, vb0, pa0, pa1, pa2, pa3);
    if (even) { MASKT(pB0, pB1, NT - 1); partialSM(pB0, pB1, m_reg, mnB, alB, C2, scl); __syncthreads(); RESC(alB);
        finishSM(pB0, pB1, alB, l_reg, pa0, pa1, pa2, pa3); SBAR(); pv_tile<1, PVM>(o, vb0, pa0, pa1, pa2, pa3); }
#undef HALF_STEP
    } else {
    f32x16 p0, p1; float mn, al; bf16x8 pa0, pa1, pa2, pa3;
    constexpr int NKI = SHMK / 8192;
    unsigned kof[NKI], vof[2];
#pragma unroll
    for (int i = 0; i < NKI; ++i) { const int x = (wid * NKI + i) * 1024 + lane * 16, row = x / RB, pc = x - row * RB; kof[i] = (unsigned)(row * (int)ldk + ((pc ^ ((row & 7) << 4)) >> 1)) * 2u; }
#pragma unroll
    for (int i = 0; i < 2; ++i) { const int x = (wid * 2 + i) * 1024 + lane * 16, stl = x >> 9, y = x & 511, kk = (stl >> 2) * 8 + (y >> 6);
        const int k = (kk & ~0xC) | ((kk & 4) << 1) | ((kk & 8) >> 1), c = (stl & 3) * 32 + ((y & 63) >> 1); vof[i] = (unsigned)(k * (int)ldv + c) * 2u; }
#define DMA_TILE(bf, t) do { const long k0_ = (long)KT(t) * 64;                                                                  \
        _Pragma("unroll") for (int i = 0; i < NKI; ++i) __builtin_amdgcn_global_load_lds((const unsigned*)((const char*)(Kg + k0_ * ldk) + kof[i]),      \
            (LAS unsigned*)((LAS char*)K_lds + (bf) * SHMK + (wid * NKI + i) * 1024), 16, 0, 0);                                 \
        if constexpr (PVM != 1) { _Pragma("unroll") for (int i = 0; i < 2; ++i) __builtin_amdgcn_global_load_lds((const unsigned*)((const char*)(Vg + k0_ * ldv) + vof[i]), \
            (LAS unsigned*)((LAS char*)V_lds + (bf) * SHM_V + (wid * 2 + i) * 1024), 16, 0, 0); } } while (0)
    __syncthreads();
    DMA_TILE(0, 0);
    __syncthreads();
#define STEP(t, KB) do {                                                                                                       \
        if ((t) + 1 < NT) DMA_TILE(1 - KB, (t) + 1);                                                                           \
        SBAR(); qkt<DQK, KB>(p0, p1, K_lds, r32, hi, qr);                                                                      \
        MASKT(p0, p1, (t)); partialSM(p0, p1, m_reg, mn, al, C2, scl); RESC(al);                                               \
        finishSM(p0, p1, al, l_reg, pa0, pa1, pa2, pa3); SBAR();                                                               \
        pv_tile<KB, PVM>(o, vb0, pa0, pa1, pa2, pa3);                                                                          \
        asm volatile("s_waitcnt vmcnt(0)" ::: "memory"); __syncthreads(); } while (0)
    int t = 0;
    for (; t + 1 < NT; t += 2) { STEP(t, 0); STEP(t + 1, 1); }
    if (t < NT) STEP(t, 0);
#undef DMA_TILE
#undef STEP
    }
    l_out = l_reg;
#undef KT
#undef VMW
#undef SLOAD
#undef SWRITE
#undef RESC
#undef MASKT
}

#define WS_PTR(T_, off) ((T_*)(p.ws + (off)))
#define ROW_SCALES(sc, lval, gval, USE_G) do { if (hi == 0) { wsp[r32] = (lval); if (USE_G) wsp[64 + r32] = (gval); }                \
        asm volatile("s_waitcnt lgkmcnt(0)" ::: "memory");                                                                        \
        _Pragma("unroll") for (int r = 0; r < 16; ++r) { const float li_ = wsp[crow(r, hi)]; float s_ = li_ > 0.f ? __builtin_amdgcn_rcpf(li_) : 0.f; \
            if (USE_G) s_ *= wsp[64 + crow(r, hi)]; sc[r] = s_; } } while (0)

__device__ __forceinline__ void mla_unit(const Params& p, char* lds, const int b, const int h, const int qb) {
    const int tid = TID(), wid = __builtin_amdgcn_readfirstlane(tid >> 6), lane = tid & 63, r32 = lane & 31, hi = lane >> 5;
    const int t0 = qb * 256, tokw = t0 + wid * 32, tok = tokw + r32;
    const bf16* qp = WS_PTR(const bf16, WS_QMLA) + ((long)(b * S + tok) * 8 + h) * 192 + hi * 8;
    bf16x8 qr[12];
#pragma unroll
    for (int d0 = 0; d0 < 12; ++d0) qr[d0] = *reinterpret_cast<const bf16x8*>(qp + d0 * 16);
    {
        const float* cA = WS_PTR(const float, WS_COSA) + (long)(b * S + tok) * 32 + hi * 8; const float* sA = WS_PTR(const float, WS_SINA) + (long)(b * S + tok) * 32 + hi * 8;
#pragma unroll
        for (int dd = 0; dd < 2; ++dd) {
            const f32x4 c0 = *reinterpret_cast<const f32x4*>(cA + dd * 16), c1 = *reinterpret_cast<const f32x4*>(cA + dd * 16 + 4);
            const f32x4 s0 = *reinterpret_cast<const f32x4*>(sA + dd * 16), s1 = *reinterpret_cast<const f32x4*>(sA + dd * 16 + 4);
            const u32x4 a = *reinterpret_cast<const u32x4*>(&qr[8 + dd]), bq = *reinterpret_cast<const u32x4*>(&qr[10 + dd]);
            u32x4 oa, ob;
#pragma unroll
            for (int e = 0; e < 4; ++e) { const float x1l = bflo(a[e]), x1h = bfhi(a[e]), x2l = bflo(bq[e]), x2h = bfhi(bq[e]);
                const float cl = e < 2 ? c0[2 * e] : c1[2 * e - 4], ch = e < 2 ? c0[2 * e + 1] : c1[2 * e - 3];
                const float sl = e < 2 ? s0[2 * e] : s1[2 * e - 4], sh = e < 2 ? s0[2 * e + 1] : s1[2 * e - 3];
                oa[e] = cvtpk(x1l * cl - x2l * sl, x1h * ch - x2h * sh); ob[e] = cvtpk(x2l * cl + x1l * sl, x2h * ch + x1h * sh); }
            qr[8 + dd] = *reinterpret_cast<const bf16x8*>(&oa); qr[10 + dd] = *reinterpret_cast<const bf16x8*>(&ob);
        }
    }
    f32x16 o[4]; float l;
    const float scl = 0.07216878364870323f;
    flash_pass<192, 1, 0>(tid, lds, qr, WS_PTR(const bf16, WS_KMLA) + ((long)b * S * 8 + h) * 192, 8 * 192,
                              WS_PTR(const bf16, WS_VMLA) + ((long)b * S * 8 + h) * 128, 8 * 128, t0 / 64 + 4, 0, tok, tokw, 0x40000000u, 0u,
                              scl * 1.4426950408889634f, scl, o, l);
    float* wsp = (float*)(lds + L_WS) + wid * 128; float sc[16];
    ROW_SCALES(sc, l, 0.f, false);
    bf16* yo = WS_PTR(bf16, WS_Y) + (long)(b * S + tokw) * 2048 + h * 128;
    float* ys = WS_PTR(float, WS_YSSQ) + (long)(b * S + tokw) * 16 + h;
#pragma unroll
    for (int r = 0; r < 16; ++r) { const int row = crow(r, hi); float ss = 0.f;
#pragma unroll
        for (int d0 = 0; d0 < 4; ++d0) { const float v = o[d0][r] * sc[r]; const float vn = swap1(v); ss += v * v;
            if (!(lane & 1)) *(unsigned*)(yo + (long)row * 2048 + d0 * 32 + r32) = cvtpk(v, vn); }
        ss += swap1(ss); ss += __shfl_xor(ss, 2); ss += __shfl_xor(ss, 4); ss += __shfl_xor(ss, 8); ss += __shfl_xor(ss, 16);
        if (r32 == 0) ys[(long)row * 16] = ss; }
}

__device__ __forceinline__ void xattn_unit(const Params& p, char* lds, const int l, const int b, const int h, const int qb) {
    const int tid = TID(), wid = __builtin_amdgcn_readfirstlane(tid >> 6), lane = tid & 63, r32 = lane & 31, hi = lane >> 5;
    const int t0 = qb * 256, tokw = t0 + wid * 32, tok = tokw + r32;
    const bf16* qp = WS_PTR(const bf16, WS_QX) + ((long)(b * S + tok) * 4 + h) * 128 + hi * 8;
    bf16x8 qr[8];
#pragma unroll
    for (int d0 = 0; d0 < 8; ++d0) qr[d0] = *reinterpret_cast<const bf16x8*>(qp + d0 * 16);
    f32x16 o[4]; float lsum;
    const float scl = 0.08838834764831845f;
    const bf16* kv = WS_PTR(const bf16, WS_KVX) + (long)l * 1024 * 1024 + (long)b * 256 * 1024 + h * 128;
    flash_pass<128, 0, 0>(tid, lds, qr, kv, 1024, kv + 512, 1024, 4, 0, 0, 0, 0u, 0u, scl * 1.4426950408889634f, scl, o, lsum);
    float* wsp = (float*)(lds + L_WS) + wid * 128; float sc[16];
    ROW_SCALES(sc, lsum, 0.f, false);
    bf16* yo = WS_PTR(bf16, WS_OX) + (long)(b * S + tokw) * 512 + h * 128;
#pragma unroll
    for (int r = 0; r < 16; ++r) { const int row = crow(r, hi);
#pragma unroll
        for (int d0 = 0; d0 < 4; ++d0) { const float v = o[d0][r] * sc[r]; const float vn = swap1(v);
            if (!(lane & 1)) *(unsigned*)(yo + (long)row * 512 + d0 * 32 + r32) = cvtpk(v, vn); } }
}

#define NSA_CTX() const int tid = TID(), wid = __builtin_amdgcn_readfirstlane(tid >> 6), lane = tid & 63, r32 = lane & 31, hi = lane >> 5;             \
    const int hh = wid & 3, tsub = wid >> 2, head = g * 4 + hh; const int t0 = tb * 64, tokw = t0 + tsub * 32, tok = tokw + r32;                      \
    const bf16* qp = WS_PTR(const bf16, WS_QN) + ((long)(b * S + tok) * 8 + head) * 128 + hi * 8;                                                     \
    const float* gp = WS_PTR(const float, WS_GATES) + (long)(b * S + tok) * 24 + head * 3;                                                            \
    float* wsp = (float*)(lds + L_WS) + wid * 128; float* yo = WS_PTR(float, WS_YNSA) + (long)(b * S + tokw) * 1024 + head * 128;                      \
    const float scl = 0.08838834764831845f, C2 = scl * 1.4426950408889634f; (void)t0; (void)gp; (void)wsp; (void)yo; (void)tid;                        \
    bf16x8 qr[8]; _Pragma("unroll") for (int d0 = 0; d0 < 8; ++d0) qr[d0] = *reinterpret_cast<const bf16x8*>(qp + d0 * 16)
__device__ __forceinline__ void nsa_unit(const Params& p, char* lds, const int b, const int g, const int tb) {
    const bf16* kv6 = WS_PTR(const bf16, WS_KV6);
    const bf16* kcp = WS_PTR(const bf16, WS_KCMP) + (long)(b * 2 + g) * 128 * 128;
    {
        NSA_CTX();
        const int nvis = tok >= 31 ? ((tok - 31) >> 4) + 1 : 0;
        f32x16 o[5]; float lsum;
        flash_pass<128, 1, 2, 1>(tid, lds, qr, kcp, 128, kcp + 8 * 128 * 128, 128, 2, 0, nvis - 1, -(1 << 20), 0x40000000u, 0u, C2, scl, o, lsum);
        float sc[16];
        ROW_SCALES(sc, lsum, 0.f, false);
        float* imp = (float*)(lds + L_IMP) + wid * (32 * 33);
#pragma unroll
        for (int r = 0; r < 16; ++r) imp[crow(r, hi) * 33 + r32] = o[4][r] * sc[r];
        if (tid == 0) ((volatile unsigned*)(lds + L_MISC))[1] = 0u;
        const float g_c = gp[0];
        { if (hi == 0) wsp[64 + r32] = g_c; asm volatile("s_waitcnt lgkmcnt(0)" ::: "memory");
#pragma unroll
          for (int r = 0; r < 16; ++r) sc[r] *= wsp[64 + crow(r, hi)]; }
#pragma unroll
        for (int r = 0; r < 16; ++r) { const int row = crow(r, hi);
#pragma unroll
            for (int d0 = 0; d0 < 4; ++d0) yo[(long)row * 1024 + d0 * 32 + r32] = o[d0][r] * sc[r]; }
    }
    __syncthreads();
    {
        const int tid = TID();
        if (tid < 64) {
            const int ts = tid >> 5, rr = tid & 31; const float* ib = (const float*)(lds + L_IMP) + (ts * 4) * (32 * 33) + rr * 33;
            float v[32];
#pragma unroll
            for (int n = 0; n < 32; ++n) v[n] = ib[n] + ib[32 * 33 + n] + ib[2 * 32 * 33 + n] + ib[3 * 32 * 33 + n];
            const int cur = tb;
#pragma unroll
            for (int n = 0; n < 32; ++n) { const bool forced = (n == 0) || (n == cur); const bool vis = n <= cur; v[n] = forced ? 1e4f : (vis ? v[n] : -1e4f); }
            unsigned m = 0u;
#pragma unroll
            for (int k = 0; k < 8; ++k) { float best = -3.0e38f; int bi = 0;
#pragma unroll
                for (int n = 0; n < 32; ++n) { if (v[n] > best) { best = v[n]; bi = n; } }
                m |= 1u << bi;
#pragma unroll
                for (int n = 0; n < 32; ++n) v[n] = (n == bi) ? -3.3e38f : v[n]; }
            ((volatile unsigned*)(lds + L_SELM))[tid] = m;
            atomicOr((unsigned*)(lds + L_MISC) + 1, m);
        }
        __syncthreads();
        if (tid == 0) { volatile unsigned* misc = (volatile unsigned*)(lds + L_MISC); unsigned um = misc[1] & ((2u << tb) - 1u); int n = 0; volatile int* tl = (volatile int*)(lds + L_TL);
            while (um) { tl[n++] = __builtin_ctz(um); um &= um - 1u; } misc[2] = (unsigned)n; }
        __syncthreads();
    }
    {
        NSA_CTX();
        const unsigned selm = ((volatile unsigned*)(lds + L_SELM))[tsub * 32 + r32];
        const int ntl = __builtin_amdgcn_readfirstlane((int)((volatile unsigned*)(lds + L_MISC))[2]);
        f32x16 o[4]; float lsum;
        const bf16* kb = kv6 + 2 * KV6_STRIDE + ((long)b * S * 2 + g) * 128;
        flash_pass<128, 2, 0>(tid, lds, qr, kb, 256, kb + KV6_STRIDE, 256, ntl, 0, tok, tokw, 0x40000000u, selm, C2, scl, o, lsum);
        float sc[16]; const float g_s = gp[1];
        ROW_SCALES(sc, lsum, g_s, true);
#pragma unroll
        for (int r = 0; r < 16; ++r) { const int row = crow(r, hi);
#pragma unroll
            for (int d0 = 0; d0 < 4; ++d0) { float* a = yo + (long)row * 1024 + d0 * 32 + r32; *a = *a + o[d0][r] * sc[r]; } }
    }
    {
        NSA_CTX();
        f32x16 o[4]; float lsum;
        const bf16* kb = kv6 + 4 * KV6_STRIDE + ((long)b * S * 2 + g) * 128;
        const int jlo = tb > 8 ? tb - 8 : 0;
        flash_pass<128, 1, 0, 1>(tid, lds, qr, kb, 256, kb + KV6_STRIDE, 256, tb - jlo + 1, jlo, tok, tokw, 512u, 0u, C2, scl, o, lsum);
        float sc[16]; const float g_w = gp[2];
        ROW_SCALES(sc, lsum, g_w, true);
        bf16* yb = WS_PTR(bf16, WS_Y) + (long)(b * S + tokw) * 2048 + 1024 + head * 128;
        float* ys = WS_PTR(float, WS_YSSQ) + (long)(b * S + tokw) * 16 + 8 + head;
#pragma unroll
        for (int r = 0; r < 16; ++r) { const int row = crow(r, hi); float ss = 0.f;
#pragma unroll
            for (int d0 = 0; d0 < 4; ++d0) { const float v = yo[(long)row * 1024 + d0 * 32 + r32] + o[d0][r] * sc[r]; const float vn = swap1(v); ss += v * v;
                if (!(lane & 1)) *(unsigned*)(yb + (long)row * 2048 + d0 * 32 + r32) = cvtpk(v, vn); }
            ss += swap1(ss); ss += __shfl_xor(ss, 2); ss += __shfl_xor(ss, 4); ss += __shfl_xor(ss, 8); ss += __shfl_xor(ss, 16);
            if (r32 == 0) ys[(long)row * 16] = ss; }
    }
}
#undef NSA_CTX

__device__ __forceinline__ u32x2 pack4(f32x4 v) { return u32x2{cvtpk(v[0], v[1]), cvtpk(v[2], v[3])}; }
__device__ __forceinline__ f32x4 unpack4(u32x2 w) { return f32x4{bflo(w[0]), bfhi(w[0]), bflo(w[1]), bfhi(w[1])}; }

template <bool MOE, bool SB = false>
__device__ __forceinline__ void norm_rows(const Params& p, const void* __restrict__ src_, const int nrows, const float* __restrict__ gain,
                                          bf16* dbf, float* df32, bf16* hout, const int* offs) {
    const float* src = (const float*)src_; const bf16* srcb = (const bf16*)src_;
    const int tid = TID(), wid = tid >> 6, lane = tid & 63;
    f32x4 gv[8];
#pragma unroll
    for (int i = 0; i < 8; ++i) gv[i] = *reinterpret_cast<const f32x4*>(gain + (lane + 64 * i) * 4);
    int2 ne = {0, 0}, nr = {0, 0};
    if constexpr (MOE) { const int r0 = blockIdx.x * 8 + wid; if (r0 < nrows) { ne = *reinterpret_cast<const int2*>(WS_PTR(const int, WS_TOKE) + r0 * 2); nr = *reinterpret_cast<const int2*>(WS_PTR(const int, WS_TOKR) + r0 * 2); } }
    for (int row = blockIdx.x * 8 + wid; row < nrows; row += gridDim.x * 8) {
        f32x4 v[8];
#pragma unroll
        for (int i = 0; i < 8; ++i) { if constexpr (SB) v[i] = unpack4(*reinterpret_cast<const u32x2*>(srcb + (long)row * DM + (lane + 64 * i) * 4));
            else v[i] = *reinterpret_cast<const f32x4*>(src + (long)row * DM + (lane + 64 * i) * 4); }
        if constexpr (MOE) {
            const int2 ce = ne, cr = nr; const int nrow = row + gridDim.x * 8;
            if (nrow < nrows) { ne = *reinterpret_cast<const int2*>(WS_PTR(const int, WS_TOKE) + nrow * 2); nr = *reinterpret_cast<const int2*>(WS_PTR(const int, WS_TOKR) + nrow * 2); }
            const long s0 = offs[ce.x] + cr.x, s1 = offs[ce.y] + cr.y;
            const bf16* y0 = WS_PTR(const bf16, WS_YBUF) + s0 * DM; const bf16* y1 = WS_PTR(const bf16, WS_YBUF) + s1 * DM;
#pragma unroll
            for (int i = 0; i < 8; ++i) { const f32x4 a = unpack4(*reinterpret_cast<const u32x2*>(y0 + (lane + 64 * i) * 4));
                const f32x4 c = unpack4(*reinterpret_cast<const u32x2*>(y1 + (lane + 64 * i) * 4)); v[i] = v[i] + a + c; }
            if (hout) {
#pragma unroll
                for (int i = 0; i < 8; ++i) *reinterpret_cast<u32x2*>(hout + (long)row * DM + (lane + 64 * i) * 4) = pack4(v[i]);
            }
        }
        float ss = 0.f;
#pragma unroll
        for (int i = 0; i < 8; ++i) ss += v[i][0] * v[i][0] + v[i][1] * v[i][1] + v[i][2] * v[i][2] + v[i][3] * v[i][3];
        ss = wave_sum(ss);
        const float inv = rsqrtf(ss * (1.f / DM) + 1e-6f);
#pragma unroll
        for (int i = 0; i < 8; ++i) { const f32x4 o = v[i] * inv * gv[i];
            if (dbf) *reinterpret_cast<u32x2*>(dbf + (long)row * DM + (lane + 64 * i) * 4) = pack4(o);
            if (df32) *reinterpret_cast<f32x4*>(df32 + (long)row * DM + (lane + 64 * i) * 4) = o; }
    }
}
__device__ __forceinline__ void moe_prefix(const Params& p, char* lds, const int l) {
    int* offs = (int*)(lds + L_PFX); int* toff = offs + 65;
    const int* cnt = WS_PTR(const int, CTL_CNT) + l * 64;
    __syncthreads();
    if (TID() < 64) { const int e = TID(); const int c = cnt[e]; int a = c, t = (c + 383) / 384;
#pragma unroll
        for (int d = 1; d < 64; d <<= 1) { const int ua = __shfl_up(a, d), ut = __shfl_up(t, d); if (e >= d) { a += ua; t += ut; } }
        offs[e + 1] = a; toff[e + 1] = t; if (e == 0) { offs[0] = 0; toff[0] = 0; } }
    __syncthreads();
}

__device__ __forceinline__ void prologue_misc(const Params& p, char* lds) {
    const int tid = TID(); const long gtid = (long)blockIdx.x * NTHR + tid, gsz = (long)gridDim.x * NTHR;
    float* cosA = WS_PTR(float, WS_COSA); float* sinA = WS_PTR(float, WS_SINA); float* cosN = WS_PTR(float, WS_COSN); float* sinN = WS_PTR(float, WS_SINN);
    for (long i = gtid; i < (long)T * 48; i += gsz) {
        const int t = (int)(i / 48), f = (int)(i - (long)t * 48);
        const float ex = f < 32 ? (float)(2 * f) * (1.f / 64.f) : (float)(2 * (f - 32)) * (1.f / 32.f);
        const float invf = exp2f(-ex * 18.931568569324174f);
        const float ang = (float)p.positions[t] * invf;
        const float n = rintf(ang * 0.15915494309189535f);
        const float r = fmaf(n, 1.7484555e-7f, fmaf(-n, 6.2831855f, ang));
        const float c = __cosf(r), s = __sinf(r);
        if (f < 32) { cosA[t * 32 + f] = c; sinA[t * 32 + f] = s; } else { cosN[t * 16 + f - 32] = c; sinN[t * 16 + f - 32] = s; }
    }
    bf16* kc = WS_PTR(bf16, WS_KCMP);
    for (long i = gtid; i < 16 * 128; i += gsz) kc[((i >> 7) * 128 + 127) * 128 + (i & 127)] = __float2bfloat16(0.f);
    float* part = WS_PTR(float, WS_B1PART);
    for (int u = blockIdx.x; u < 64; u += gridDim.x) {
        const int v = u >> 4, kp = u & 15, l = v >> 1, which = v & 1;
        const float* pe = (which ? p.pe_v : p.pe_k) + (long)l * 4096 + kp * 256; const float* w1 = (which ? p.w_cv1 : p.w_ck1) + (long)l * 4096 * 512 + (long)kp * 256 * 512 + tid;
        float a = 0.f;
#pragma unroll 16
        for (int k = 0; k < 256; ++k) a += pe[k] * w1[(long)k * 512];
        part[(v * 16 + kp) * 512 + tid] = a;
    }
}
__device__ __forceinline__ void bias1_finish(const Params& p) {
    const int gt = blockIdx.x * NTHR + TID();
    if (gt < 2048) { const float* part = WS_PTR(const float, WS_B1PART) + (gt >> 9) * 16 * 512 + (gt & 511); float a = 0.f;
#pragma unroll
        for (int q = 0; q < 16; ++q) a += part[q * 512];
        WS_PTR(float, WS_BIAS1)[gt] = a; }
}

__device__ __forceinline__ void phase_post(const Params& p, const int l) {
    const int tid = TID(), wid = tid >> 6, lane = tid & 63;
    const float* proj = WS_PTR(const float, WS_PROJ);
    const float* cosA = WS_PTR(const float, WS_COSA); const float* sinA = WS_PTR(const float, WS_SINA);
    const float* cosN = WS_PTR(const float, WS_COSN); const float* sinN = WS_PTR(const float, WS_SINN);
    bf16* cqn = WS_PTR(bf16, WS_CQN); bf16* ckvn = WS_PTR(bf16, WS_CKVN); bf16* kmla = WS_PTR(bf16, WS_KMLA); bf16* qn = WS_PTR(bf16, WS_QN);
    bf16* kv6 = WS_PTR(bf16, WS_KV6); float* gates = WS_PTR(float, WS_GATES);
    const float* gcq = p.g_cq + l * 512; const float* gckv = p.g_ckv + l * 256;
    for (int t = blockIdx.x * 8 + wid; t < T; t += gridDim.x * 8) {
        const float* pr = proj + (long)t * DINP;
        {
            const f32x4 a0 = *reinterpret_cast<const f32x4*>(pr + C_CQ + lane * 4), a1 = *reinterpret_cast<const f32x4*>(pr + C_CQ + 256 + lane * 4);
            float ss = a0[0] * a0[0] + a0[1] * a0[1] + a0[2] * a0[2] + a0[3] * a0[3] + a1[0] * a1[0] + a1[1] * a1[1] + a1[2] * a1[2] + a1[3] * a1[3];
            ss = wave_sum(ss); const float inv = rsqrtf(ss * (1.f / 512.f) + 1e-6f);
            const f32x4 g0 = *reinterpret_cast<const f32x4*>(gcq + lane * 4), g1 = *reinterpret_cast<const f32x4*>(gcq + 256 + lane * 4);
            *reinterpret_cast<u32x2*>(cqn + (long)t * 512 + lane * 4) = pack4(a0 * inv * g0);
            *reinterpret_cast<u32x2*>(cqn + (long)t * 512 + 256 + lane * 4) = pack4(a1 * inv * g1);
        }
        {
            const f32x4 a0 = *reinterpret_cast<const f32x4*>(pr + C_CKV + lane * 4);
            float ss = a0[0] * a0[0] + a0[1] * a0[1] + a0[2] * a0[2] + a0[3] * a0[3];
            ss = wave_sum(ss); const float inv = rsqrtf(ss * (1.f / 256.f) + 1e-6f);
            const f32x4 g0 = *reinterpret_cast<const f32x4*>(gckv + lane * 4);
            *reinterpret_cast<u32x2*>(ckvn + (long)t * 256 + lane * 4) = pack4(a0 * inv * g0);
        }
        {
            const int i = lane & 31; const float x1 = pr[C_KR + i], x2 = pr[C_KR + 32 + i];
            const float c = cosA[(long)t * 32 + i], s = sinA[(long)t * 32 + i];
            const float v = lane < 32 ? x1 * c - x2 * s : x2 * c + x1 * s; const float vn = swap1(v);
            if (!(lane & 1)) { const unsigned w = cvtpk(v, vn);
#pragma unroll
                for (int h = 0; h < 8; ++h) *(unsigned*)(kmla + ((long)t * 8 + h) * 192 + 128 + lane) = w; }
        }
        {
            const int head = lane >> 3, part = lane & 7; const float* qp = pr + C_QN + head * 128 + part * 16;
            f32x4 q[4];
#pragma unroll
            for (int e = 0; e < 4; ++e) q[e] = *reinterpret_cast<const f32x4*>(qp + e * 4);
            float o[16];
#pragma unroll
            for (int e = 0; e < 16; ++e) { const float mine = q[e >> 2][e & 3]; const float oth = swap1(mine);
                const float c = cosN[(long)t * 16 + e], s = sinN[(long)t * 16 + e];
                o[e] = part == 0 ? mine * c - oth * s : (part == 1 ? mine * c + oth * s : mine); }
            u32x4 w0 = {cvtpk(o[0], o[1]), cvtpk(o[2], o[3]), cvtpk(o[4], o[5]), cvtpk(o[6], o[7])};
            u32x4 w1 = {cvtpk(o[8], o[9]), cvtpk(o[10], o[11]), cvtpk(o[12], o[13]), cvtpk(o[14], o[15])};
            bf16* d = qn + ((long)t * 8 + head) * 128 + part * 16;
            *reinterpret_cast<u32x4*>(d) = w0; *reinterpret_cast<u32x4*>(d + 8) = w1;
        }
#pragma unroll
        for (int X = 0; X < 6; ++X) {
            const f32x4 a = *reinterpret_cast<const f32x4*>(pr + C_KC + X * 256 + lane * 4);
            f32x4 o = a;
            if ((X & 1) == 0) {
                const int dl = (lane & 31) * 4;
#pragma unroll
                for (int e = 0; e < 4; ++e) { const float oth = __shfl_xor(a[e], 4); const int f = (dl & 15) + e;
                    const float c = cosN[(long)t * 16 + f], s = sinN[(long)t * 16 + f];
                    o[e] = dl < 16 ? a[e] * c - oth * s : (dl < 32 ? a[e] * c + oth * s : a[e]); }
            }
            *reinterpret_cast<u32x2*>(kv6 + X * KV6_STRIDE + (long)t * 256 + lane * 4) = pack4(o);
        }
        if (lane < 24) gates[(long)t * 24 + lane] = 1.f / (1.f + __expf(-pr[C_GT + lane]));
    }
}

__device__ __forceinline__ void phase_combine(const Params& p, const int l) {
    const int tid = TID(), wid = tid >> 6, lane = tid & 63;
    const bf16* ya = WS_PTR(const bf16, WS_YMLA); const float* yb = WS_PTR(const float, WS_YNSA); bf16* y = WS_PTR(bf16, WS_Y);
    const float* ga = p.g_ya + l * 1024 + lane * 16; const float* gb = p.g_yb + l * 1024 + lane * 16;
    for (int t = blockIdx.x * 8 + wid; t < T; t += gridDim.x * 8) {
        float a[16], c[16];
        { const u32x4 w0 = *reinterpret_cast<const u32x4*>(ya + (long)t * 1024 + lane * 16), w1 = *reinterpret_cast<const u32x4*>(ya + (long)t * 1024 + lane * 16 + 8);
#pragma unroll
          for (int e = 0; e < 4; ++e) { a[2 * e] = bflo(w0[e]); a[2 * e + 1] = bfhi(w0[e]); a[8 + 2 * e] = bflo(w1[e]); a[8 + 2 * e + 1] = bfhi(w1[e]); } }
#pragma unroll
        for (int e = 0; e < 4; ++e) { const f32x4 q = *reinterpret_cast<const f32x4*>(yb + (long)t * 1024 + lane * 16 + e * 4); c[4 * e] = q[0]; c[4 * e + 1] = q[1]; c[4 * e + 2] = q[2]; c[4 * e + 3] = q[3]; }
        float sa = 0.f, sb = 0.f;
#pragma unroll
        for (int e = 0; e < 16; ++e) { sa += a[e] * a[e]; sb += c[e] * c[e]; }
        sa = wave_sum(sa); sb = wave_sum(sb);
        const float ia = rsqrtf(sa * (1.f / 1024.f) + 1e-6f), ib = rsqrtf(sb * (1.f / 1024.f) + 1e-6f);
        unsigned wa[8], wb[8];
#pragma unroll
        for (int e = 0; e < 8; ++e) { wa[e] = cvtpk(a[2 * e] * ia * ga[2 * e], a[2 * e + 1] * ia * ga[2 * e + 1]); wb[e] = cvtpk(c[2 * e] * ib * gb[2 * e], c[2 * e + 1] * ib * gb[2 * e + 1]); }
        bf16* d = y + (long)t * 2048 + lane * 16;
        *reinterpret_cast<u32x4*>(d) = u32x4{wa[0], wa[1], wa[2], wa[3]}; *reinterpret_cast<u32x4*>(d + 8) = u32x4{wa[4], wa[5], wa[6], wa[7]};
        *reinterpret_cast<u32x4*>(d + 1024) = u32x4{wb[0], wb[1], wb[2], wb[3]}; *reinterpret_cast<u32x4*>(d + 1032) = u32x4{wb[4], wb[5], wb[6], wb[7]};
    }
}


constexpr int VG_ABLK = 128 * 128, VG_STAGE = 3 * VG_ABLK + 128 * 128;
struct VgStage { f32x4 b[4]; float g[4]; };
template <int VAR, int NBC, class AF, class BF, class EF>
__device__ __forceinline__ void vgemm_tile_n(char* lds, const int nk, const int nblk_rt, const AF& af, const BF& bf, const EF& ef) {
    const int nblk = NBC > 0 ? NBC : __builtin_amdgcn_readfirstlane(nblk_rt);
    const int tid = TID(), lane = tid & 63, wid = tid >> 6;
    const int wm = wid >> 1, wn = wid & 1;
    const int ac = tid & 7, ar0 = tid >> 3;
    const char* abase = (const char*)af.base; unsigned aoff[3][2];
#pragma unroll
    for (int b = 0; b < 3; ++b)
#pragma unroll
        for (int i = 0; i < 2; ++i) aoff[b][i] = (unsigned)((const char*)(af.row(b * 128 + ar0 + 64 * i) + ac * 8) - abase);
    const int alds0 = ar0 * 128 + ((ac ^ ((ar0 >> 1) & 7)) << 4);
    const int n4 = tid & 31, kg = tid >> 5;
    long ldb = 0; const float* bptr = bf.col(n4 * 4, ldb);
    int blds[4];
#pragma unroll
    for (int e = 0; e < 4; ++e) { const int n = n4 * 4 + e; const int sw = (n >> 1) & 7; blds[e] = 3 * VG_ABLK + n * 128 + ((((kg >> 1) ^ sw) << 4) + (kg & 1) * 8); }
    VgStage S0, S1; bf16x8 As[3][2];
#define VG_GLOADA(SS, kt) do {                                                                                                 \
        _Pragma("unroll") for (int b = 0; b < 3; ++b) { if (b < nblk) { _Pragma("unroll") for (int i = 0; i < 2; ++i) asm volatile("global_load_dwordx4 %0, %1, off" : "=v"(As[b][i]) : "v"(abase + aoff[b][i] + (kt) * 128) : "memory"); } } } while (0)
#define VG_GLOADB(SS, kt) do {                                                                                                 \
        _Pragma("unroll") for (int kk = 0; kk < 4; ++kk) { asm volatile("global_load_dwordx4 %0, %1, off nt" : "=v"(SS.b[kk]) : "v"(bptr + (long)((kt) * 64 + kg * 4 + kk) * ldb) : "memory"); } } while (0)
#define VG_GLOAD(SS, kt) do { VG_GLOADA(SS, kt); VG_GLOADB(SS, kt); } while (0)
#define VG_LSTORE(SS, buf) do {                                                                                                \
        _Pragma("unroll") for (int b = 0; b < 3; ++b) { if (b < nblk) { _Pragma("unroll") for (int i = 0; i < 2; ++i) *reinterpret_cast<bf16x8*>((buf) + b * VG_ABLK + alds0 + i * 64 * 128) = As[b][i]; } } \
        _Pragma("unroll") for (int e = 0; e < 4; ++e) { u32x2 w = {cvtpk(SS.b[0][e], SS.b[1][e]), cvtpk(SS.b[2][e], SS.b[3][e])}; *reinterpret_cast<u32x2*>((buf) + blds[e]) = w; } } while (0)
    f32x4 acc[3][2][4];
#pragma unroll
    for (int b = 0; b < 3; ++b)
#pragma unroll
        for (int i = 0; i < 2; ++i)
#pragma unroll
            for (int j = 0; j < 4; ++j) acc[b][i][j] = f32x4{0.f, 0.f, 0.f, 0.f};
    const int fsw = (lane >> 1) & 7, fq = lane >> 4;
    const int foff0 = (lane & 15) * 128 + (((0 + fq) ^ fsw) << 4), foff1 = (lane & 15) * 128 + (((4 + fq) ^ fsw) << 4);
#define VG_COMPUTE(buf) do {                                                                                                   \
        _Pragma("unroll") for (int ks = 0; ks < 2; ++ks) { const int fo = ks ? foff1 : foff0; bf16x8 bb[4];                    \
            _Pragma("unroll") for (int j = 0; j < 4; ++j) bb[j] = *reinterpret_cast<const bf16x8*>((buf) + 3 * VG_ABLK + (wn * 64 + j * 16) * 128 + fo); \
            _Pragma("unroll") for (int b = 0; b < 3; ++b) { if (b < nblk) { bf16x8 aa[2];                                      \
                _Pragma("unroll") for (int i = 0; i < 2; ++i) aa[i] = *reinterpret_cast<const bf16x8*>((buf) + b * VG_ABLK + (wm * 32 + i * 16) * 128 + fo); \
                _Pragma("unroll") for (int i = 0; i < 2; ++i) { _Pragma("unroll") for (int j = 0; j < 4; ++j)                  \
                    acc[b][i][j] = __builtin_amdgcn_mfma_f32_16x16x32_bf16(aa[i], bb[j], acc[b][i][j], 0, 0, 0); } } } } } while (0)
    char* buf0 = lds; char* buf1 = lds + VG_STAGE;
#define VGW(SS, later) do { if (later) asm volatile("s_waitcnt vmcnt(4)" ::: "memory"); else asm volatile("s_waitcnt vmcnt(0)" ::: "memory");             \
                                       \
        _Pragma("unroll") for (int b = 0; b < 3; ++b) { if (b < nblk) { _Pragma("unroll") for (int i = 0; i < 2; ++i) asm volatile("" : "+v"(As[b][i])); } }          \
        _Pragma("unroll") for (int kk = 0; kk < 4; ++kk) asm volatile("" : "+v"(SS.b[kk])); } while (0)
#define VGLA(kt) do { if constexpr (VAR == 3) { if ((kt) < 1) VG_GLOADA(S0, kt); } else VG_GLOADA(S0, kt); } while (0)
#define VGLB(SS, kt) do { if constexpr (VAR == 2) { if ((kt) < 2) VG_GLOADB(SS, kt); } else VG_GLOADB(SS, kt); } while (0)
#define VGS(SS, buf) do { if constexpr (VAR != 4) VG_LSTORE(SS, buf); } while (0)
#define VGC(buf) do { if constexpr (VAR != 1) VG_COMPUTE(buf); } while (0)
    asm volatile("s_waitcnt vmcnt(0)" ::: "memory");
    VGLA(0); VGLB(S0, 0); if (nk > 1) VGLB(S1, 1);
    VGW(S0, nk > 1); VG_LSTORE(S0, buf0); if (nk > 1) VGLA(1); if (nk > 2) VGLB(S0, 2);
    __syncthreads();
    for (int kt = 0; kt < nk; kt += 2) {
        VGC(buf0);
        if (kt + 1 < nk) { VGW(S1, kt + 2 < nk); VGS(S1, buf1); if (kt + 2 < nk) VGLA(kt + 2); if (kt + 3 < nk) VGLB(S1, kt + 3); }
        __syncthreads();
        if (kt + 1 < nk) {
            VGC(buf1);
            if (kt + 2 < nk) { VGW(S0, kt + 3 < nk); VGS(S0, buf0); if (kt + 3 < nk) VGLA(kt + 3); if (kt + 4 < nk) VGLB(S0, kt + 4); }
            __syncthreads();
        }
    }
    asm volatile("s_waitcnt vmcnt(0)" ::: "memory");
#undef VGW
#undef VGLA
#undef VGLB
#undef VGS
#undef VGC
#undef VG_GLOAD
#undef VG_GLOADA
#undef VG_GLOADB
#undef VG_LSTORE
#undef VG_COMPUTE
#pragma unroll
    for (int b = 0; b < 3; ++b) if (b < nblk) ef.run(b, acc[b], wm, wn, lane);
}

template <class E> __device__ __forceinline__ auto epi_finish(const E& e, int nb, int) -> decltype(e.finish(nb), void()) { e.finish(nb); }
template <class E> __device__ __forceinline__ void epi_finish(const E&, int, long) {}
template <int NB, class AF, class BF, class EF>
__device__ __forceinline__ void hgemm_tile(char* lds_, const int nk, const AF& af, const BF& bf, const EF& ef) {
    LAS char* lds = (LAS char*)lds_;
    const int tid = TID(), lane = tid & 63, wid = __builtin_amdgcn_readfirstlane(tid >> 6);
    const int wm = wid >> 1, wn = wid & 1;
    const char* abase = (const char*)af.base; unsigned aoff[NB][2];
#pragma unroll
    for (int b = 0; b < NB; ++b)
#pragma unroll
        for (int i = 0; i < 2; ++i) { const int rb = (wid * 2 + i) * 8 + (lane >> 3);
            aoff[b][i] = (unsigned)((const char*)af.row(b * 128 + rb) - abase) + (unsigned)(((lane & 7) ^ ((rb >> 1) & 7)) * 16); }
    const int n4 = tid & 31, kg = tid >> 5;
    long ldb = 0; const float* bptr = bf.col(n4 * 4, ldb);
    int blds[4];
#pragma unroll
    for (int e = 0; e < 4; ++e) { const int n = n4 * 4 + e; const int sw = (n >> 1) & 7; blds[e] = 3 * VG_ABLK + n * 128 + ((((kg >> 1) ^ sw) << 4) + (kg & 1) * 8); }
    f32x4 S0[4], S1[4];
#define HG_DMA_A(buf, kt) do { _Pragma("unroll") for (int b = 0; b < NB; ++b) { _Pragma("unroll") for (int i = 0; i < 2; ++i)                      \
        __builtin_amdgcn_global_load_lds((const unsigned*)(abase + aoff[b][i] + (size_t)af.koff((kt) * 64) * 2), (LAS unsigned*)((buf) + b * VG_ABLK + (wid * 2 + i) * 1024), 16, 0, 0); } } while (0)
#define HG_LOADB(SS, kt) do { _Pragma("unroll") for (int kk = 0; kk < 4; ++kk)                                                                    \
        asm volatile("global_load_dwordx4 %0, %1, off nt" : "=v"(SS[kk]) : "v"(bptr + (long)((kt) * 64 + kg * 4 + kk) * ldb) : "memory"); } while (0)
#define HG_STOREB(SS, buf) do { _Pragma("unroll") for (int kk = 0; kk < 4; ++kk) asm volatile("" : "+v"(SS[kk]));                                 \
        _Pragma("unroll") for (int e = 0; e < 4; ++e) { u32x2 w = {cvtpk(SS[0][e], SS[1][e]), cvtpk(SS[2][e], SS[3][e])}; *(LAS u32x2*)((buf) + blds[e]) = w; } } while (0)
#define HG_WAIT(n) asm volatile("s_waitcnt vmcnt(%0)" :: "n"(n) : "memory")
#define HG_BAR() do { asm volatile("s_waitcnt lgkmcnt(0)" ::: "memory"); __builtin_amdgcn_s_barrier(); asm volatile("" ::: "memory"); } while (0)
    f32x4 acc[NB][2][4];
#pragma unroll
    for (int b = 0; b < NB; ++b)
#pragma unroll
        for (int i = 0; i < 2; ++i)
#pragma unroll
            for (int j = 0; j < 4; ++j) acc[b][i][j] = f32x4{0.f, 0.f, 0.f, 0.f};
    const int fsw = (lane >> 1) & 7, fq = lane >> 4;
    const int foff0 = (lane & 15) * 128 + (((0 + fq) ^ fsw) << 4), foff1 = (lane & 15) * 128 + (((4 + fq) ^ fsw) << 4);
#define HG_COMPUTE(buf) do {                                                                                                   \
        bf16x8 bb0[4], bb1[4], aa0[NB][2], aa1[NB][2];                                                                         \
        _Pragma("unroll") for (int j = 0; j < 4; ++j) bb0[j] = *(const LAS bf16x8*)((buf) + 3 * VG_ABLK + (wn * 64 + j * 16) * 128 + foff0); \
        _Pragma("unroll") for (int b = 0; b < NB; ++b) { _Pragma("unroll") for (int i = 0; i < 2; ++i) aa0[b][i] = *(const LAS bf16x8*)((buf) + b * VG_ABLK + (wm * 32 + i * 16) * 128 + foff0); } \
        _Pragma("unroll") for (int j = 0; j < 4; ++j) bb1[j] = *(const LAS bf16x8*)((buf) + 3 * VG_ABLK + (wn * 64 + j * 16) * 128 + foff1); \
        _Pragma("unroll") for (int b = 0; b < NB; ++b) { _Pragma("unroll") for (int i = 0; i < 2; ++i) aa1[b][i] = *(const LAS bf16x8*)((buf) + b * VG_ABLK + (wm * 32 + i * 16) * 128 + foff1); } \
        _Pragma("unroll") for (int b = 0; b < NB; ++b) { _Pragma("unroll") for (int i = 0; i < 2; ++i) { _Pragma("unroll") for (int j = 0; j < 4; ++j) \
            acc[b][i][j] = __builtin_amdgcn_mfma_f32_16x16x32_bf16(aa0[b][i], bb0[j], acc[b][i][j], 0, 0, 0); } }              \
        _Pragma("unroll") for (int b = 0; b < NB; ++b) { _Pragma("unroll") for (int i = 0; i < 2; ++i) { _Pragma("unroll") for (int j = 0; j < 4; ++j) \
            acc[b][i][j] = __builtin_amdgcn_mfma_f32_16x16x32_bf16(aa1[b][i], bb1[j], acc[b][i][j], 0, 0, 0); } } } while (0)
#define HG_STEP(t, CUR, NXT, SN) do {                                                                                          \
        if ((t) + 1 < nk) HG_DMA_A(NXT, (t) + 1);                                                                              \
        HG_COMPUTE(CUR);                                                                                                       \
        if ((t) + 1 < nk) {                                                                                                    \
            if ((t) + 2 < nk) HG_WAIT(4 + 2 * NB); else HG_WAIT(2 * NB);           \
            HG_STOREB(SN, NXT);                                                                                                \
            if ((t) + 3 < nk) { HG_LOADB(SN, (t) + 3); HG_WAIT(4); } else HG_WAIT(0);                        \
        }                                                                                                                      \
        HG_BAR(); } while (0)
    LAS char* buf0 = lds; LAS char* buf1 = lds + VG_STAGE;
    asm volatile("s_waitcnt vmcnt(0) lgkmcnt(0)" ::: "memory"); __builtin_amdgcn_s_barrier(); asm volatile("" ::: "memory");
    HG_DMA_A(buf0, 0); HG_LOADB(S0, 0);
    if (nk > 1) { HG_LOADB(S1, 1); HG_WAIT(4); } else HG_WAIT(0);
    HG_STOREB(S0, buf0);
    if (nk > 2) HG_LOADB(S0, 2);
    HG_BAR();
    for (int kt = 0; kt < nk; kt += 2) {
        HG_STEP(kt, buf0, buf1, S1);
        if (kt + 1 < nk) HG_STEP(kt + 1, buf1, buf0, S0);
    }
    asm volatile("s_waitcnt vmcnt(0)" ::: "memory");
#undef HG_DMA_A
#undef HG_LOADB
#undef HG_STOREB
#undef HG_WAIT
#undef HG_BAR
#undef HG_COMPUTE
#undef HG_STEP
#pragma unroll
    for (int b = 0; b < NB; ++b) ef.run(b, acc[b], wm, wn, lane);
    epi_finish(ef, NB, 0);
}

template <class AF, class BF, class EF>
__device__ __forceinline__ void hgemm1_tile(char* lds_, const int nk, const AF& af, const BF& bf, const EF& ef) {
    constexpr int STG = 2 * VG_ABLK;
    LAS char* lds = (LAS char*)lds_;
    const int tid = TID(), lane = tid & 63, wid = __builtin_amdgcn_readfirstlane(tid >> 6);
    const int wm = wid >> 1, wn = wid & 1;
    const char* abase = (const char*)af.base; unsigned aoff[2];
#pragma unroll
    for (int i = 0; i < 2; ++i) { const int rb = (wid * 2 + i) * 8 + (lane >> 3);
        aoff[i] = (unsigned)((const char*)af.row(rb) - abase) + (unsigned)(((lane & 7) ^ ((rb >> 1) & 7)) * 16); }
    const int n4 = tid & 31, kg = tid >> 5;
    long ldb = 0; const float* bptr = bf.col(n4 * 4, ldb);
    int blds[4];
#pragma unroll
    for (int e = 0; e < 4; ++e) { const int n = n4 * 4 + e; const int sw = (n >> 1) & 7; blds[e] = VG_ABLK + n * 128 + ((((kg >> 1) ^ sw) << 4) + (kg & 1) * 8); }
    f32x4 S0[4], S1[4];
#define H1_DMA_A(st, kt) do { _Pragma("unroll") for (int i = 0; i < 2; ++i)                                                                      \
        __builtin_amdgcn_global_load_lds((const unsigned*)(abase + aoff[i] + (size_t)af.koff((kt) * 64) * 2), (LAS unsigned*)(lds + (st) * STG + (wid * 2 + i) * 1024), 16, 0, 0); } while (0)
#define H1_LOADB(SS, kt) do { _Pragma("unroll") for (int kk = 0; kk < 4; ++kk)                                                                    \
        asm volatile("global_load_dwordx4 %0, %1, off nt" : "=v"(SS[kk]) : "v"(bptr + (long)((kt) * 64 + kg * 4 + kk) * ldb) : "memory"); } while (0)
#define H1_STOREB(SS, st) do { _Pragma("unroll") for (int kk = 0; kk < 4; ++kk) asm volatile("" : "+v"(SS[kk]));                                  \
        _Pragma("unroll") for (int e = 0; e < 4; ++e) { u32x2 w = {cvtpk(SS[0][e], SS[1][e]), cvtpk(SS[2][e], SS[3][e])}; *(LAS u32x2*)(lds + (st) * STG + blds[e]) = w; } } while (0)
#define H1_WAIT(n) asm volatile("s_waitcnt vmcnt(%0)" :: "n"(n) : "memory")
#define H1_BAR() do { asm volatile("s_waitcnt lgkmcnt(0)" ::: "memory"); __builtin_amdgcn_s_barrier(); asm volatile("" ::: "memory"); } while (0)
    f32x4 acc[2][4];
#pragma unroll
    for (int i = 0; i < 2; ++i)
#pragma unroll
        for (int j = 0; j < 4; ++j) acc[i][j] = f32x4{0.f, 0.f, 0.f, 0.f};
    const int fsw = (lane >> 1) & 7, fq = lane >> 4;
    const int foff0 = (lane & 15) * 128 + (((0 + fq) ^ fsw) << 4), foff1 = (lane & 15) * 128 + (((4 + fq) ^ fsw) << 4);
#define H1_COMPUTE(st) do { const LAS char* sb_ = lds + (st) * STG;                                                          \
        bf16x8 bb0[4], bb1[4], aa0[2], aa1[2];                                                                                 \
        _Pragma("unroll") for (int j = 0; j < 4; ++j) bb0[j] = *(const LAS bf16x8*)(sb_ + VG_ABLK + (wn * 64 + j * 16) * 128 + foff0); \
        _Pragma("unroll") for (int i = 0; i < 2; ++i) aa0[i] = *(const LAS bf16x8*)(sb_ + (wm * 32 + i * 16) * 128 + foff0);   \
        _Pragma("unroll") for (int j = 0; j < 4; ++j) bb1[j] = *(const LAS bf16x8*)(sb_ + VG_ABLK + (wn * 64 + j * 16) * 128 + foff1); \
        _Pragma("unroll") for (int i = 0; i < 2; ++i) aa1[i] = *(const LAS bf16x8*)(sb_ + (wm * 32 + i * 16) * 128 + foff1);   \
        _Pragma("unroll") for (int i = 0; i < 2; ++i) { _Pragma("unroll") for (int j = 0; j < 4; ++j) acc[i][j] = __builtin_amdgcn_mfma_f32_16x16x32_bf16(aa0[i], bb0[j], acc[i][j], 0, 0, 0); } \
        _Pragma("unroll") for (int i = 0; i < 2; ++i) { _Pragma("unroll") for (int j = 0; j < 4; ++j) acc[i][j] = __builtin_amdgcn_mfma_f32_16x16x32_bf16(aa1[i], bb1[j], acc[i][j], 0, 0, 0); } } while (0)
#define H1_STEP(t, ST, SN, SN2, SN_) do { if ((t) < nk) {                                                                      \
        if ((t) + 2 < nk) H1_DMA_A(SN2, (t) + 2);                                                                              \
        H1_COMPUTE(ST);                                                                                                        \
        if ((t) + 1 < nk) {                                                                                                    \
            if ((t) + 2 < nk) H1_WAIT(6); else H1_WAIT(0);                \
            H1_STOREB(SN_, SN);                                                                                                \
            if ((t) + 3 < nk) H1_LOADB(SN_, (t) + 3);                                                                          \
        }                                                                                                                      \
        H1_BAR(); } } while (0)
    asm volatile("s_waitcnt vmcnt(0) lgkmcnt(0)" ::: "memory"); __builtin_amdgcn_s_barrier(); asm volatile("" ::: "memory");
    H1_DMA_A(0, 0); if (nk > 1) H1_DMA_A(1, 1);
    H1_LOADB(S0, 0); if (nk > 1) H1_LOADB(S1, 1);
    if (nk > 1) H1_WAIT(4); else H1_WAIT(0);
    H1_STOREB(S0, 0);
    if (nk > 2) H1_LOADB(S0, 2);
    H1_BAR();
    for (int kt = 0; kt < nk; kt += 6) {
        H1_STEP(kt, 0, 1, 2, S1);
        H1_STEP(kt + 1, 1, 2, 0, S0);
        H1_STEP(kt + 2, 2, 0, 1, S1);
        H1_STEP(kt + 3, 0, 1, 2, S0);
        H1_STEP(kt + 4, 1, 2, 0, S1);
        H1_STEP(kt + 5, 2, 0, 1, S0);
    }
    asm volatile("s_waitcnt vmcnt(0)" ::: "memory");
#undef H1_DMA_A
#undef H1_LOADB
#undef H1_STOREB
#undef H1_WAIT
#undef H1_BAR
#undef H1_COMPUTE
#undef H1_STEP
    ef.run(0, acc, wm, wn, lane);
}
struct AVGather {
    const bf16* base; const int* list; int r0, cnt;
    __device__ __forceinline__ const bf16* row(int r) const { int R = r0 + r; R = R < cnt ? R : cnt - 1; return base + (long)list[R] * DM; }
    __device__ __forceinline__ long koff(int k0) const { return k0; }
};
struct AVPlain {
    const bf16* base; long ld; int nrows;
    __device__ __forceinline__ const bf16* row(int r) const { const int R = r < nrows ? r : nrows - 1; return base + (long)R * ld; }
    __device__ __forceinline__ long koff(int k0) const { return k0; }
};
struct HEpiBf16 {
    bf16* Cc; long ldc; int m0, n0, mmax; const float* rinv;
    __device__ __forceinline__ void run(int, f32x4 (&acc)[2][4], int wm, int wn, int lane) const {
#pragma unroll
        for (int i = 0; i < 2; ++i)
#pragma unroll
            for (int r = 0; r < 4; ++r) { const int trow = wm * 32 + i * 16 + (lane >> 4) * 4 + r, R = m0 + trow; const bool ok = R < mmax; const float ri = rinv ? rinv[trow] : 1.f;
#pragma unroll
                for (int j = 0; j < 4; ++j) { const float v = acc[i][j][r] * ri; const float vn = swap1(v);
                    if (ok && !(lane & 1)) *(unsigned*)(Cc + (long)R * ldc + n0 + wn * 64 + j * 16 + (lane & 15)) = cvtpk(v, vn); } }
    }
};
struct HEpiF32 {
    float* Cc; long ldc; int m0, n0, mmax;
    __device__ __forceinline__ void run(int, f32x4 (&acc)[2][4], int wm, int wn, int lane) const {
#pragma unroll
        for (int i = 0; i < 2; ++i)
#pragma unroll
            for (int r = 0; r < 4; ++r) { const int R = m0 + wm * 32 + i * 16 + (lane >> 4) * 4 + r;
                if (R < mmax) {
#pragma unroll
                    for (int j = 0; j < 4; ++j) Cc[(long)R * ldc + n0 + wn * 64 + j * 16 + (lane & 15)] = acc[i][j][r]; } }
    }
};
struct BVGateUp { const float* W1; const float* W3; int n0; const float* gk;
    __device__ __forceinline__ const float* col(int c, long& ldo) const { ldo = 512; const int wn = c >> 6, w = c & 63;
        const long d = (w & 32) ? (long)(W3 - W1) : 0L; return W1 + d + n0 + wn * 32 + (w & 31); } };
struct BVPlain { const float* W; long ld; int n0; const float* gk;
    __device__ __forceinline__ const float* col(int c, long& ldo) const { ldo = ld; return W + n0 + c; } };
struct EVMoe1S {
    bf16* hb; const float* rinv; int n0, valid; char* lds;
    __device__ __forceinline__ void run(int b, f32x4 (&acc)[2][4], int wm, int wn, int lane) const {
        constexpr int RS = 144;
        LAS char* st = (LAS char*)lds + b * (128 * RS);
        const bool odd = lane & 1;
#pragma unroll
        for (int i = 0; i < 2; ++i) {
            float ri[4];
#pragma unroll
            for (int r = 0; r < 4; ++r) { const int row = b * 128 + wm * 32 + i * 16 + (lane >> 4) * 4 + r; ri[r] = row < valid ? rinv[row] : 0.f; }
#pragma unroll
            for (int j = 0; j < 2; ++j)
#pragma unroll
                for (int rp = 0; rp < 2; ++rp) {
                    const float g0 = acc[i][j][2 * rp] * ri[2 * rp], u0 = acc[i][j + 2][2 * rp] * ri[2 * rp];
                    const float g1 = acc[i][j][2 * rp + 1] * ri[2 * rp + 1], u1 = acc[i][j + 2][2 * rp + 1] * ri[2 * rp + 1];
                    const float v0 = g0 / (1.f + __expf(-g0)) * u0, v1 = g1 / (1.f + __expf(-g1)) * u1;
                    const float got = swap1(odd ? v0 : v1);
                    const unsigned w = odd ? cvtpk(got, v1) : cvtpk(v0, got);
                    const int lrow = wm * 32 + i * 16 + (lane >> 4) * 4 + 2 * rp + (odd ? 1 : 0), lcol = wn * 32 + j * 16 + (lane & 14);
                    *(LAS unsigned*)(st + lrow * RS + lcol * 2) = w;
                }
        }
    }
    __device__ __forceinline__ void finish(const int nb) const {
        constexpr int RS = 144;
        asm volatile("s_waitcnt lgkmcnt(0)" ::: "memory"); __builtin_amdgcn_s_barrier(); asm volatile("" ::: "memory");
        const int tid = TID(), rr = tid >> 3, ck = tid & 7;
#pragma unroll
        for (int b = 0; b < 3; ++b) { if (b < nb) { const LAS char* st = (const LAS char*)lds + b * (128 * RS);
#pragma unroll
            for (int ps = 0; ps < 2; ++ps) { const int lrow = ps * 64 + rr, row = b * 128 + lrow;
                if (row < valid) { const u32x4 w = *(const LAS u32x4*)(st + lrow * RS + ck * 16); *(u32x4*)(hb + (long)row * 512 + n0 + ck * 8) = w; } } } }
    }
};
struct EVMoe1 {
    bf16* hb; const float* rinv; int n0, valid;
    __device__ __forceinline__ void run(int b, f32x4 (&acc)[2][4], int wm, int wn, int lane) const {
#pragma unroll
        for (int i = 0; i < 2; ++i)
#pragma unroll
            for (int r = 0; r < 4; ++r) { const int row = b * 128 + wm * 32 + i * 16 + (lane >> 4) * 4 + r; const bool ok = row < valid;
                const float ri = ok ? rinv[row] : 0.f;
#pragma unroll
                for (int j = 0; j < 2; ++j) { const float g = acc[i][j][r] * ri, u = acc[i][j + 2][r] * ri; const float v = g / (1.f + __expf(-g)) * u; const float vn = swap1(v);
                    if (ok && !(lane & 1)) *(unsigned*)(hb + (long)row * 512 + n0 + wn * 32 + j * 16 + (lane & 15)) = cvtpk(v, vn); } }
    }
};
struct EVMoe2S {
    bf16* yb; const float* gate; int n0, valid; char* lds;
    __device__ __forceinline__ void run(int b, f32x4 (&acc)[2][4], int wm, int wn, int lane) const {
        constexpr int RS = 272;
        LAS char* st = (LAS char*)lds + b * (128 * RS);
        const bool odd = lane & 1;
#pragma unroll
        for (int i = 0; i < 2; ++i) {
            float gt[4];
#pragma unroll
            for (int r = 0; r < 4; ++r) { const int row = b * 128 + wm * 32 + i * 16 + (lane >> 4) * 4 + r; gt[r] = row < valid ? gate[row] : 0.f; }
#pragma unroll
            for (int j = 0; j < 4; ++j)
#pragma unroll
                for (int rp = 0; rp < 2; ++rp) {
                    const float v0 = acc[i][j][2 * rp] * gt[2 * rp], v1 = acc[i][j][2 * rp + 1] * gt[2 * rp + 1];
                    const float got = swap1(odd ? v0 : v1);
                    const unsigned w = odd ? cvtpk(got, v1) : cvtpk(v0, got);
                    const int lrow = wm * 32 + i * 16 + (lane >> 4) * 4 + 2 * rp + (odd ? 1 : 0), lcol = wn * 64 + j * 16 + (lane & 14);
                    *(LAS unsigned*)(st + lrow * RS + lcol * 2) = w;
                }
        }
    }
    __device__ __forceinline__ void finish(const int nb) const {
        constexpr int RS = 272;
        asm volatile("s_waitcnt lgkmcnt(0)" ::: "memory"); __builtin_amdgcn_s_barrier(); asm volatile("" ::: "memory");
        const int tid = TID(), rr = tid >> 4, ck = tid & 15;
#pragma unroll
        for (int b = 0; b < 3; ++b) { if (b < nb) { const LAS char* st = (const LAS char*)lds + b * (128 * RS);
#pragma unroll
            for (int ps = 0; ps < 4; ++ps) { const int lrow = ps * 32 + rr, row = b * 128 + lrow;
                if (row < valid) { const u32x4 w = *(const LAS u32x4*)(st + lrow * RS + ck * 16); *(u32x4*)(yb + (long)row * DM + n0 + ck * 8) = w; } } } }
    }
};
struct EVMoe2 {
    bf16* yb; const float* gate; int n0, valid;
    __device__ __forceinline__ void run(int b, f32x4 (&acc)[2][4], int wm, int wn, int lane) const {
#pragma unroll
        for (int i = 0; i < 2; ++i)
#pragma unroll
            for (int r = 0; r < 4; ++r) { const int row = b * 128 + wm * 32 + i * 16 + (lane >> 4) * 4 + r; const bool ok = row < valid; const float gt = ok ? gate[row] : 0.f;
#pragma unroll
                for (int j = 0; j < 4; ++j) { const float v = acc[i][j][r] * gt; const float vn = swap1(v);
                    if (ok && !(lane & 1)) *(unsigned*)(yb + (long)row * DM + n0 + wn * 64 + j * 16 + (lane & 15)) = cvtpk(v, vn); } }
    }
};

namespace pg8 {
#define PG8_LAS __attribute__((address_space(3)))
typedef unsigned short bf16_t;
constexpr int BM = 256, BK = 64, HALF = 128, HTB = HALF * BK * 2, STAGE_BYTES = 8 * HTB, NXCD = 8, WGM = 8;
__host__ __device__ __forceinline__ int lds_byte(int r, int c) { const int st = (r >> 4) * 2 + (c >> 5), rr = r & 15, cc = c & 31, ob = rr * 64 + cc * 2; return st * 1024 + (ob ^ (((ob >> 9) & 1) << 5)); }
__host__ __device__ __forceinline__ void stage_rc(int b, int& R, int& C) { const int st = b / 1024, sb = b % 1024, swz = sb ^ (((sb >> 9) & 1) << 5); R = (st >> 1) * 16 + swz / 64; C = (st & 1) * 32 + (swz % 64) / 2; }
__host__ __device__ __forceinline__ int perm32(int rho) { const int n = rho >> 4, i = rho & 15; return 8 * (i >> 2) + 4 * n + (i & 3); }
struct Unit { int pm, pn; };
struct Gemm { const bf16_t* A; const bf16_t* Bt; int M, N, K; };
struct StaticOrder {
    int nM, nN, nwg, G, c;
    __host__ __device__ void init(int M, int N, int G_, int c_) { nM = M / BM; nN = N / BM; nwg = nM * nN; G = G_; c = c_; }
    __host__ __device__ bool next(int i, Unit& u) const {
        const long L = (long)i * G + c; if (L >= nwg) return false;
        int wgid = (int)L; { const int q = nwg / NXCD, r = nwg % NXCD, xcd = wgid % NXCD, off = wgid / NXCD; wgid = (xcd < r ? xcd * (q + 1) : r * (q + 1) + (xcd - r) * q) + off; }
        const int nig = WGM * nN, gid = wgid / nig, fm = gid * WGM, gsz = (nM - fm) < WGM ? (nM - fm) : WGM;
        u.pm = fm + ((wgid % nig) % gsz); u.pn = (wgid % nig) / gsz; return true;
    }
    __device__ __forceinline__ void a_ready(const Unit&) const {}
    __device__ __forceinline__ void done(const Unit&) const {}
};
template <bool RB> struct EpiResHT {
    static constexpr bool PERM = true;
    bf16_t* C; const void* R; bf16_t* HB; float* hssq; const float* YL; const float* G; int ldc;
    __device__ __forceinline__ void mid(f32x4 (&acc)[2][2][4][2], const Unit& u, int wr, int wc, int fr, int fq) const {
        if (!YL) return;
#pragma unroll
        for (int ai = 0; ai < 2; ++ai)
#pragma unroll
            for (int m = 0; m < 4; ++m) { const float ratio = YL[wr * 64 + ai * HALF + m * 16 + fr];
#pragma unroll
                for (int bj = 0; bj < 2; ++bj)
#pragma unroll
                    for (int n = 0; n < 2; ++n) acc[ai][bj][m][n] = acc[ai][bj][m][n] * ratio; }
    }
    __device__ __forceinline__ void operator()(const f32x4 (&acc)[2][2][4][2], const Unit& u, int wr, int wc, int fr, int fq) const {
        const int row0 = u.pm * BM + wr * 64 + fr, col0 = u.pn * BM + wc * 32 + 8 * fq;
        f32x4 gv[2][2];
#pragma unroll
        for (int bj = 0; bj < 2; ++bj)
#pragma unroll
            for (int n = 0; n < 2; ++n) gv[bj][n] = *(const f32x4*)(G + col0 + bj * HALF + n * 4);
#pragma unroll
        for (int ai = 0; ai < 2; ++ai) {
            u32x4 rb[4][2]; f32x4 rv[RB ? 1 : 4][2][2];
#pragma unroll
            for (int m = 0; m < 4; ++m) { const size_t ro = (size_t)(row0 + ai * HALF + m * 16) * ldc + col0;
#pragma unroll
                for (int bj = 0; bj < 2; ++bj) { if constexpr (RB) rb[m][bj] = *(const u32x4*)((const bf16_t*)R + ro + bj * HALF);
                    else { rv[m][bj][0] = *(const f32x4*)((const float*)R + ro + bj * HALF); rv[m][bj][1] = *(const f32x4*)((const float*)R + ro + bj * HALF + 4); } } }
#pragma unroll
            for (int m = 0; m < 4; ++m) { const size_t t = (size_t)(row0 + ai * HALF + m * 16), ro = t * ldc + col0;
                const float sc = YL ? YL[256 + wr * 64 + ai * HALF + m * 16 + fr] : 1.f;
                float ss = 0.f;
#pragma unroll
                for (int bj = 0; bj < 2; ++bj) {
                    f32x4 r0, r1;
                    if constexpr (RB) { r0 = ::unpack4(u32x2{rb[m][bj].x, rb[m][bj].y}); r1 = ::unpack4(u32x2{rb[m][bj].z, rb[m][bj].w}); } else { r0 = rv[m][bj][0]; r1 = rv[m][bj][1]; }
                    const f32x4 v0 = acc[ai][bj][m][0] * sc + r0, v1 = acc[ai][bj][m][1] * sc + r1;
                    *(u32x4*)(C + ro + bj * HALF) = u32x4{cvtpk(v0[0], v0[1]), cvtpk(v0[2], v0[3]), cvtpk(v1[0], v1[1]), cvtpk(v1[2], v1[3])};
                    ss += ((v0[0] * v0[0] + v0[1] * v0[1]) + (v0[2] * v0[2] + v0[3] * v0[3])) + ((v1[0] * v1[0] + v1[1] * v1[1]) + (v1[2] * v1[2] + v1[3] * v1[3]));
                    const f32x4 g0 = v0 * gv[bj][0], g1 = v1 * gv[bj][1];
                    *(u32x4*)(HB + ro + bj * HALF) = u32x4{cvtpk(g0[0], g0[1]), cvtpk(g0[2], g0[3]), cvtpk(g1[0], g1[1]), cvtpk(g1[2], g1[3])}; }
                ss += __shfl_xor(ss, 16); ss += __shfl_xor(ss, 32);
                if (fq == 0) hssq[t * 32 + u.pn * 4 + wc] = ss; }
            asm volatile("" ::: "memory");
        }
    }
};
template <class E> struct has_mid { static constexpr bool v = false; };
template <> struct has_mid<EpiResHT<false>> { static constexpr bool v = true; };
template <> struct has_mid<EpiResHT<true>> { static constexpr bool v = true; };
struct EpiBf16 {
    static constexpr bool PERM = true;
    bf16_t* O; int ldc;
    __device__ __forceinline__ void operator()(const f32x4 (&acc)[2][2][4][2], const Unit& u, int wr, int wc, int fr, int fq) const {
        const int row0 = u.pm * BM + wr * 64 + fr, col0 = u.pn * BM + wc * 32 + 8 * fq;
#pragma unroll
        for (int ai = 0; ai < 2; ++ai)
#pragma unroll
            for (int m = 0; m < 4; ++m) { bf16_t* rowp = O + (size_t)(row0 + ai * HALF + m * 16) * ldc + col0;
#pragma unroll
                for (int bj = 0; bj < 2; ++bj) { const f32x4 v0 = acc[ai][bj][m][0], v1 = acc[ai][bj][m][1];
                    u32x4 w; w.x = cvtpk(v0[0], v0[1]); w.y = cvtpk(v0[2], v0[3]); w.z = cvtpk(v1[0], v1[1]); w.w = cvtpk(v1[2], v1[3]);
                    *(u32x4*)(rowp + bj * HALF) = w; } }
    }
};
struct EpiInProj {
    static constexpr bool PERM = true;
    bf16_t* cq; bf16_t* ckv; float* ssq; bf16_t* qn; bf16_t* kv6; bf16_t* kmla; float* gates;
    const float* cosA; const float* sinA; const float* cosN; const float* sinN;
    __device__ __forceinline__ void operator()(const f32x4 (&acc)[2][2][4][2], const Unit& u, int wr, int wc, int fr, int fq) const {
        const int row0 = u.pm * BM + wr * 64 + fr, pn = u.pn;
#pragma unroll
        for (int ai = 0; ai < 2; ++ai)
#pragma unroll
            for (int m = 0; m < 4; ++m) {
                const size_t t = (size_t)(row0 + ai * HALF + m * 16);
                if (pn <= 2) {
                    float ss = 0.f;
#pragma unroll
                    for (int bj = 0; bj < 2; ++bj) { const f32x4 v0 = acc[ai][bj][m][0], v1 = acc[ai][bj][m][1];
                        ss += v0[0] * v0[0] + v0[1] * v0[1] + v0[2] * v0[2] + v0[3] * v0[3] + v1[0] * v1[0] + v1[1] * v1[1] + v1[2] * v1[2] + v1[3] * v1[3];
                        u32x4 w; w.x = cvtpk(v0[0], v0[1]); w.y = cvtpk(v0[2], v0[3]); w.z = cvtpk(v1[0], v1[1]); w.w = cvtpk(v1[2], v1[3]);
                        bf16_t* d = pn < 2 ? cq + t * 512 + pn * 256 + bj * HALF + wc * 32 + 8 * fq : ckv + t * 256 + bj * HALF + wc * 32 + 8 * fq;
                        *(u32x4*)d = w; }
                    ss += __shfl_xor(ss, 16); ss += __shfl_xor(ss, 32);
                    if (fq == 0) ssq[t * 16 + (pn < 2 ? pn * 4 + wc : 8 + wc)] = ss;
                } else if (pn <= 12) {
#pragma unroll
                    for (int bj = 0; bj < 2; ++bj) { const int blk = (pn - 3) * 2 + bj; const f32x4 v0 = acc[ai][bj][m][0], v1 = acc[ai][bj][m][1];
                        const bool rope = (blk < 8) || ((((blk - 8) >> 1) & 1) == 0);
                        bf16_t* d = blk < 8 ? qn + (t * 8 + blk) * 128 : kv6 + (size_t)((blk - 8) >> 1) * KV6_STRIDE + t * 256 + ((blk - 8) & 1) * 128;
                        if (rope && wc == 0) {
                            const f32x4 c = *(const f32x4*)(cosN + t * 16 + 4 * fq), sn = *(const f32x4*)(sinN + t * 16 + 4 * fq);
                            const f32x4 o1 = v0 * c - v1 * sn, o2 = v1 * c + v0 * sn;
                            *(u32x2*)(d + 4 * fq) = u32x2{cvtpk(o1[0], o1[1]), cvtpk(o1[2], o1[3])};
                            *(u32x2*)(d + 16 + 4 * fq) = u32x2{cvtpk(o2[0], o2[1]), cvtpk(o2[2], o2[3])};
                        } else {
                            u32x4 w; w.x = cvtpk(v0[0], v0[1]); w.y = cvtpk(v0[2], v0[3]); w.z = cvtpk(v1[0], v1[1]); w.w = cvtpk(v1[2], v1[3]);
                            *(u32x4*)(d + wc * 32 + 8 * fq) = w; }
                    }
                } else {
                    const f32x4 v0 = acc[ai][0][m][0], v1 = acc[ai][0][m][1];
                    if (wc < 2) {
                        const int f = (wc * 4 + fq) * 4;
                        const f32x4 c = *(const f32x4*)(cosA + t * 32 + f), sn = *(const f32x4*)(sinA + t * 32 + f);
                        const f32x4 o1 = v0 * c - v1 * sn, o2 = v1 * c + v0 * sn;
                        const u32x2 w1 = u32x2{cvtpk(o1[0], o1[1]), cvtpk(o1[2], o1[3])}, w2 = u32x2{cvtpk(o2[0], o2[1]), cvtpk(o2[2], o2[3])};
#pragma unroll
                        for (int h = 0; h < 8; ++h) { bf16_t* d = kmla + (t * 8 + h) * 192 + 128; *(u32x2*)(d + f) = w1; *(u32x2*)(d + 32 + f) = w2; }
                    } else if (wc == 2 && fq < 3) {
                        float* d = gates + t * 24 + 8 * fq;
                        f32x4 g0, g1;
#pragma unroll
                        for (int e = 0; e < 4; ++e) { g0[e] = 1.f / (1.f + __expf(-v0[e])); g1[e] = 1.f / (1.f + __expf(-v1[e])); }
                        *(f32x4*)d = g0; *(f32x4*)(d + 4) = g1;
                    }
                }
                asm volatile("" ::: "memory");
            }
    }
};
struct EpiBf16S {
    static constexpr bool PERM = true;
    bf16_t* O; int ldc; const float* ssq;
    __device__ __forceinline__ void operator()(const f32x4 (&acc)[2][2][4][2], const Unit& u, int wr, int wc, int fr, int fq) const {
        const int row0 = u.pm * BM + wr * 64 + fr, col0 = u.pn * BM + wc * 32 + 8 * fq;
#pragma unroll
        for (int ai = 0; ai < 2; ++ai)
#pragma unroll
            for (int m = 0; m < 4; ++m) { const size_t t = (size_t)(row0 + ai * HALF + m * 16);
                const f32x4 sa = *(const f32x4*)(ssq + t * 16), sb = *(const f32x4*)(ssq + t * 16 + 4);
                const float inv = rsqrtf((((sa[0] + sa[1]) + (sa[2] + sa[3])) + ((sb[0] + sb[1]) + (sb[2] + sb[3]))) * (1.f / 512.f) + 1e-6f);
                bf16_t* rowp = O + t * ldc + col0;
#pragma unroll
                for (int bj = 0; bj < 2; ++bj) { const f32x4 v0 = acc[ai][bj][m][0] * inv, v1 = acc[ai][bj][m][1] * inv;
                    u32x4 w; w.x = cvtpk(v0[0], v0[1]); w.y = cvtpk(v0[2], v0[3]); w.z = cvtpk(v1[0], v1[1]); w.w = cvtpk(v1[2], v1[3]);
                    *(u32x4*)(rowp + bj * HALF) = w; }
                asm volatile("" ::: "memory"); }
    }
};
struct EpiKV {
    static constexpr bool PERM = true;
    bf16_t* Kd; bf16_t* Vd; const float* ssq;
    __device__ __forceinline__ void operator()(const f32x4 (&acc)[2][2][4][2], const Unit& u, int wr, int wc, int fr, int fq) const {
        const int row0 = u.pm * BM + wr * 64 + fr, c0 = wc * 32 + 8 * fq, h = u.pn;
#pragma unroll
        for (int ai = 0; ai < 2; ++ai)
#pragma unroll
            for (int m = 0; m < 4; ++m) { const size_t t = (size_t)(row0 + ai * HALF + m * 16);
                const f32x4 sq = *(const f32x4*)(ssq + t * 16 + 8);
                const float inv = rsqrtf((sq[0] + sq[1] + sq[2] + sq[3]) * (1.f / 256.f) + 1e-6f);
#pragma unroll
                for (int bj = 0; bj < 2; ++bj) { const f32x4 v0 = acc[ai][bj][m][0] * inv, v1 = acc[ai][bj][m][1] * inv;
                    u32x4 w; w.x = cvtpk(v0[0], v0[1]); w.y = cvtpk(v0[2], v0[3]); w.z = cvtpk(v1[0], v1[1]); w.w = cvtpk(v1[2], v1[3]);
                    bf16_t* d = bj == 0 ? Kd + (t * 8 + h) * 192 + c0 : Vd + (t * 8 + h) * 128 + c0;
                    *(u32x4*)d = w; }
                asm volatile("" ::: "memory"); }
    }
};
template <class Epi, class Sched>
__device__ __forceinline__ void gemm_phase(PG8_LAS unsigned char* lds, const Gemm g, const Sched& S, const Epi& E) {
    const int tid = TID(), wid = __builtin_amdgcn_readfirstlane(tid >> 6), lane = tid & 63, wr = wid >> 2, wc = wid & 3, fr = lane & 15, fq = lane >> 4;
    const int K = g.K, nt = K / BK;
    unsigned voffA[2], voffB[2];
#pragma unroll
    for (int i = 0; i < 2; ++i) { int R, C; stage_rc(tid * 16 + i * 8192, R, C); const int Rb = Epi::PERM ? ((R & ~31) + perm32(R & 31)) : R;
        voffA[i] = (unsigned)(R * K + C) * 2u; voffB[i] = (unsigned)(Rb * K + C) * 2u; }
    const size_t kstep = (size_t)(BK * 2);
    const size_t hstep = (size_t)HALF * K * 2;
    const size_t tstep = 2 * hstep;
    const unsigned ldsw = (unsigned)wid * 1024u;
    const int aoff = lds_byte(wr * 64 + fr, fq * 8), boff = lds_byte(wc * 32 + fr, fq * 8);
#define PG8_SA(b, h) (((b) * 2 + (h)) * HTB)
#define PG8_SB(b, h) ((4 + (b) * 2 + (h)) * HTB)
#define PG8_STAGE(bufoff, gbase, voff) do { _Pragma("unroll") for (int _i = 0; _i < 2; ++_i) \
        __builtin_amdgcn_global_load_lds((const unsigned*)((const char*)(gbase) + (voff)[_i]), (PG8_LAS unsigned*)(lds + (bufoff) + ldsw + _i * 8192), 16, 0, 0); } while (0)
#define PG8_LDA(dst, b, h) do { _Pragma("unroll") for (int m = 0; m < 4; ++m) _Pragma("unroll") for (int k = 0; k < 2; ++k) dst[m][k] = *(const PG8_LAS bf16x8*)(lds + PG8_SA(b, h) + aoff + m * 2048 + k * 1024); } while (0)
#define PG8_LDB(dst, b, h) do { _Pragma("unroll") for (int n = 0; n < 2; ++n) _Pragma("unroll") for (int k = 0; k < 2; ++k) dst[n][k] = *(const PG8_LAS bf16x8*)(lds + PG8_SB(b, h) + boff + n * 2048 + k * 1024); } while (0)
#define PG8_MMA(ai, bj, At, Bt) do { __builtin_amdgcn_s_setprio(1); _Pragma("unroll") for (int m = 0; m < 4; ++m) _Pragma("unroll") for (int n = 0; n < 2; ++n) _Pragma("unroll") for (int k = 0; k < 2; ++k) \
        acc[ai][bj][m][n] = __builtin_amdgcn_mfma_f32_16x16x32_bf16(Bt[n][k], At[m][k], acc[ai][bj][m][n], 0, 0, 0); __builtin_amdgcn_s_setprio(0); } while (0)
#define PG8_WAIT_V(n) asm volatile("s_waitcnt vmcnt(" #n ")" ::: "memory")
#define PG8_WAIT_L(n) asm volatile("s_waitcnt lgkmcnt(" #n ")" ::: "memory")
#define PG8_BAR __builtin_amdgcn_s_barrier()
#define PG8_SCHED __builtin_amdgcn_sched_barrier(0)
    Unit cur, nxt; int ui = 0;
    if (!S.next(0, cur)) return;
    f32x4 acc[2][2][4][2];
#pragma unroll
    for (int a = 0; a < 2; ++a)
#pragma unroll
        for (int b = 0; b < 2; ++b)
#pragma unroll
            for (int m = 0; m < 4; ++m)
#pragma unroll
                for (int n = 0; n < 2; ++n) acc[a][b][m][n] = (f32x4){0.f, 0.f, 0.f, 0.f};
    bf16x8 At[4][2], B0[2][2], B1[2][2];
    const char* cA = (const char*)g.A + (size_t)cur.pm * tstep; const char* cB = (const char*)g.Bt + (size_t)cur.pn * tstep;
    S.a_ready(cur);
    PG8_STAGE(PG8_SB(0, 0), cB, voffB); PG8_STAGE(PG8_SA(0, 0), cA, voffA); PG8_STAGE(PG8_SB(0, 1), cB + hstep, voffB); PG8_STAGE(PG8_SA(0, 1), cA + hstep, voffA);
    if (wr == 1) PG8_BAR;
    PG8_WAIT_V(4); PG8_BAR;
    PG8_STAGE(PG8_SB(1, 0), cB + kstep, voffB); PG8_STAGE(PG8_SA(1, 0), cA + kstep, voffA); PG8_STAGE(PG8_SB(1, 1), cB + hstep + kstep, voffB);
    PG8_WAIT_V(6); PG8_BAR;
    for (;;) {
        const bool has_next = S.next(ui + 1, nxt);
        const char* nA = has_next ? (const char*)g.A + (size_t)nxt.pm * tstep : cA; const char* nB = has_next ? (const char*)g.Bt + (size_t)nxt.pn * tstep : cB;
        for (int t = 0; t < nt; t += 2) {
            const bool last = (t == nt - 2);
            const char* a1 = cA + (size_t)(t + 1) * kstep;
            const char* a2 = last ? nA : cA + (size_t)(t + 2) * kstep; const char* b2 = last ? nB : cB + (size_t)(t + 2) * kstep;
            const char* a3 = a2 + kstep; const char* b3 = b2 + kstep;
            if (last && has_next) S.a_ready(nxt);
            if constexpr (has_mid<Epi>::v) { if (t == nt / 2) E.mid(acc, cur, wr, wc, fr, fq); }
            PG8_LDB(B0, 0, 0); PG8_SCHED; PG8_LDA(At, 0, 0); PG8_STAGE(PG8_SA(1, 1), a1 + hstep, voffA);
            PG8_WAIT_L(8); PG8_BAR; PG8_WAIT_L(0); PG8_MMA(0, 0, At, B0); PG8_BAR; PG8_SCHED;
            PG8_LDB(B1, 0, 1); PG8_STAGE(PG8_SB(0, 0), b2, voffB);
            PG8_BAR; PG8_WAIT_L(0); PG8_MMA(0, 1, At, B1); PG8_BAR;
            PG8_LDA(At, 0, 1); PG8_STAGE(PG8_SA(0, 0), a2, voffA);
            PG8_BAR; PG8_WAIT_L(0); PG8_MMA(1, 0, At, B0); PG8_BAR; PG8_SCHED;
            PG8_STAGE(PG8_SB(0, 1), b2 + hstep, voffB);
            PG8_WAIT_V(6); PG8_BAR; PG8_MMA(1, 1, At, B1); PG8_BAR;
            PG8_LDB(B0, 1, 0); PG8_SCHED; PG8_LDA(At, 1, 0); PG8_STAGE(PG8_SA(0, 1), a2 + hstep, voffA);
            PG8_WAIT_L(8); PG8_BAR; PG8_WAIT_L(0); PG8_MMA(0, 0, At, B0); PG8_BAR; PG8_SCHED;
            PG8_LDB(B1, 1, 1); PG8_STAGE(PG8_SB(1, 0), b3, voffB);
            PG8_BAR; PG8_WAIT_L(0); PG8_MMA(0, 1, At, B1); PG8_BAR;
            PG8_LDA(At, 1, 1); PG8_STAGE(PG8_SA(1, 0), a3, voffA);
            PG8_BAR; PG8_WAIT_L(0); PG8_MMA(1, 0, At, B0); PG8_BAR; PG8_SCHED;
            PG8_STAGE(PG8_SB(1, 1), b3 + hstep, voffB);
            PG8_WAIT_V(6); PG8_BAR; PG8_MMA(1, 1, At, B1); PG8_BAR;
        }
        E(acc, cur, wr, wc, fr, fq); S.done(cur);
        if (!has_next) break;
#pragma unroll
        for (int a = 0; a < 2; ++a)
#pragma unroll
            for (int b = 0; b < 2; ++b)
#pragma unroll
                for (int m = 0; m < 4; ++m)
#pragma unroll
                    for (int n = 0; n < 2; ++n) acc[a][b][m][n] = (f32x4){0.f, 0.f, 0.f, 0.f};
        cur = nxt; cA = nA; cB = nB; ++ui;
    }
    PG8_WAIT_V(0);
    if (wr == 0) PG8_BAR;
    PG8_BAR;
#undef PG8_SA
#undef PG8_SB
#undef PG8_STAGE
#undef PG8_LDA
#undef PG8_LDB
#undef PG8_MMA
#undef PG8_WAIT_V
#undef PG8_WAIT_L
#undef PG8_BAR
#undef PG8_SCHED
}
}

__device__ __forceinline__ int inproj_src(const int n) {
    if (n < 768) return n;
    if (n < 3328) { const int np = n - 768, blk = np >> 7; int d = np & 127;
        const bool rope = (blk < 8) || ((((blk - 8) >> 1) & 1) == 0);
        if (rope && d < 32) { const int q = d >> 3, e = d & 7; d = (e < 4) ? (4 * q + e) : (16 + 4 * q + (e - 4)); }
        return C_QN + blk * 128 + d; }
    if (n < 3392) { const int i = n - 3328, q = i >> 3, e = i & 7; return C_KR + ((e < 4) ? (4 * q + e) : (32 + 4 * q + (e - 4))); }
    if (n < DIN) return n;
    return -1;
}
template <bool INPROJ>
__device__ __forceinline__ void tr_tile(const float* __restrict__ src, const int K, const int N, bf16* __restrict__ dst, const int k0, const int n0,
                                        const float* __restrict__ gain, const float* __restrict__ gain2, char* lds) {
    float* tl = (float*)lds;
    const int tid = TID();
    f32x4 v[8];
#pragma unroll
    for (int ps = 0; ps < 8; ++ps) { const int kr = (tid >> 6) + ps * 8, nc = (tid & 63) * 4, n = n0 + nc;
        const int sc = INPROJ ? inproj_src(n) : (n < N ? n : -1);
        v[ps] = sc >= 0 ? *reinterpret_cast<const f32x4*>(src + (long)(k0 + kr) * N + sc) : f32x4{0.f, 0.f, 0.f, 0.f}; }
#pragma unroll
    for (int ps = 0; ps < 8; ++ps) { const int kr = (tid >> 6) + ps * 8, nc = (tid & 63) * 4;
        if (gain) v[ps] = v[ps] * ((gain2 && k0 + kr >= 1024) ? gain2[k0 + kr - 1024] : gain[k0 + kr]);
#pragma unroll
        for (int e = 0; e < 4; ++e) tl[kr * 257 + nc + e] = v[ps][e]; }
    __syncthreads();
#pragma unroll
    for (int ps = 0; ps < 4; ++ps) { const int n = (tid >> 3) + ps * 64, kc = tid & 7; float x[8];
#pragma unroll
      for (int j = 0; j < 8; ++j) x[j] = tl[(kc * 8 + j) * 257 + n];
      u32x4 w = {cvtpk(x[0], x[1]), cvtpk(x[2], x[3]), cvtpk(x[4], x[5]), cvtpk(x[6], x[7])};
      *reinterpret_cast<u32x4*>(dst + (long)(n0 + n) * K + k0 + kc * 8) = w; }
    __syncthreads();
}
__device__ __forceinline__ void prologue_weights(const Params& p, char* lds, const int lsel, const int b0, const int nb) {
    bf16* wt = WS_PTR(bf16, WS_WT);
    constexpr int T_IN = 32 * 14, T_OUT = 32 * 8, T_UQ = 8 * 6, T_UKV = 4 * 8, T_XO = 8 * 8, T_L = T_IN + T_OUT + T_UQ + T_UKV + T_XO;
    if ((int)blockIdx.x < b0 || (int)blockIdx.x >= b0 + nb) return;
    for (int u = (int)blockIdx.x - b0; u < T_L; u += nb) {
        const int l = lsel; int r = u;
        const float* src; bf16* dst; int K, N, ntn; const float* gain = nullptr; const float* gain2 = nullptr;
        if (r < T_IN) { src = p.w_in + (long)l * DM * DIN; dst = wt + l * WT_LAYER + WT_IN; K = DM; N = DIN; ntn = 14;
            const int kt = r / ntn, nt = r - kt * ntn; tr_tile<true>(src, K, N, dst, kt * 64, nt * 256, nullptr, nullptr, lds); continue; }
        else if ((r -= T_IN) < T_OUT) { src = p.w_out + (long)l * DM * DM; dst = wt + l * WT_LAYER + WT_OUT; K = DM; N = DM; ntn = 8; gain = p.g_ya + l * 1024; gain2 = p.g_yb + l * 1024; }
        else if ((r -= T_OUT) < T_UQ) { src = p.w_uq + (long)l * 512 * 1536; dst = wt + l * WT_LAYER + WT_UQ; K = 512; N = 1536; ntn = 6; gain = p.g_cq + l * 512; }
        else if ((r -= T_UQ) < T_UKV) { src = p.w_ukv + (long)l * 256 * 2048; dst = wt + l * WT_LAYER + WT_UKV; K = 256; N = 2048; ntn = 8; gain = p.g_ckv + l * 256; }
        else { r -= T_UKV; src = p.w_xo + (long)l * 512 * DM; dst = wt + l * WT_LAYER + WT_XO; K = 512; N = DM; ntn = 8; }
        const int kt = r / ntn, nt = r - kt * ntn;
        tr_tile<false>(src, K, N, dst, kt * 64, nt * 256, gain, gain2, lds);
    }
}

typedef GC<256, 128, 4, 2> G256;
typedef GC<128, 128, 2, 4> G128;
typedef GC<128, 256, 2, 4> GMOE;

template <class C, class MK>
__device__ __forceinline__ void gemm_phase_plain(char* lds, const bf16* A, const long lda, const int M, const float* W, const int N, const int K,
                                                 const int u0, const int ustride, const MK& mk, const float* gk = nullptr) {
    const int ntn = (N + C::BN - 1) / C::BN, ntm = (M + C::BM - 1) / C::BM;
    for (int u = u0; u < ntm * ntn; u += ustride) {
        const int mt = u / ntn, nt = u - mt * ntn;
        ARowsPlain af{A, lda, mt * C::BM, M}; BPlain bf{W, (long)N, nt * C::BN, N, gk};
        gemm_tile<C>(lds, K / 64, af, bf, mk(mt * C::BM, nt * C::BN));
    }
}

__device__ __forceinline__ void phase_inproj(const Params& p, char* lds, const int l) {
    const int G = gridDim.x, bx = blockIdx.x;
    {
        pg8::Gemm g{WS_PTR(const pg8::bf16_t, WS_XN), WS_PTR(const pg8::bf16_t, WS_WT) + l * WT_LAYER + WT_IN, T, DINP, DM};
        pg8::StaticOrder so; so.init(T, DINP, G, bx);
        pg8::EpiInProj ep{WS_PTR(pg8::bf16_t, WS_CQN), WS_PTR(pg8::bf16_t, WS_CKVN), WS_PTR(float, WS_SSQ), WS_PTR(pg8::bf16_t, WS_QN), WS_PTR(pg8::bf16_t, WS_KV6),
                          WS_PTR(pg8::bf16_t, WS_KMLA), WS_PTR(float, WS_GATES), WS_PTR(const float, WS_COSA), WS_PTR(const float, WS_SINA),
                          WS_PTR(const float, WS_COSN), WS_PTR(const float, WS_SINN)};
        pg8::gemm_phase(( PG8_LAS unsigned char*)lds, g, so, ep);
    }
    if (l == 0) {
        bias1_finish(p);
        for (int ll = 0; ll < 2; ++ll) {
            bf16* kvx = WS_PTR(bf16, WS_KVX) + (long)ll * 1024 * 1024;
            for (int u = (bx + 64) % G; u < 64; u += G) {
                const int mt = u >> 3, nt = u & 7;
                ARowsPlain af{WS_PTR(const bf16, WS_MEMN), DM, mt * 128, 1024}; BPlain bf{p.w_xkv + (long)ll * DM * 1024, 1024, nt * 128, 1024, nullptr};
                hgemm1_tile(lds, DM / 64, af, bf, HEpiBf16{kvx, 1024, mt * 128, nt * 128, 1024, nullptr});
            }
        }
    }
}
struct ARowsCmpK {
    const bf16* base; int m0, kbase;
    __device__ __forceinline__ const bf16* row(int r) const { int R = m0 + r; R = R < CMP_ROWS ? R : CMP_ROWS - 1;
        const int bg = R / NCMP, c = R - bg * NCMP, b = bg >> 1, g = bg & 1; return base + ((long)(b * S + c * 16) * 2 + g) * 128; }
    __device__ __forceinline__ long koff(int k0) const { const int k = kbase + k0; return (long)(k >> 7) * 256 + (k & 127); }
};
__device__ __forceinline__ void phase_cmp1(const Params& p, char* lds, const int l, const int u0) {
    const int G = gridDim.x;
    for (int u = u0; u < 256; u += G) {
        const int which = u >> 7, ks = (u >> 5) & 3, mt = (u >> 2) & 7, nt = u & 3;
        ARowsCmpK af{WS_PTR(const bf16, WS_KV6) + which * KV6_STRIDE, mt * 128, ks * 1024};
        BPlain bf{(which ? p.w_cv1 : p.w_ck1) + (long)l * 4096 * 512 + (long)ks * 1024 * 512, 512, nt * 128, 512, nullptr};
        HEpiF32 ef{WS_PTR(float, WS_CMP1P) + ((long)(ks * 2 + which) * 1024) * 512, 512, mt * 128, nt * 128, 1024};
        hgemm1_tile(lds, 16, af, bf, ef);
    }
}
__device__ __forceinline__ void phase_upproj(const Params& p, char* lds, const int l) {
    const int G = gridDim.x, bx = blockIdx.x;
    {
        pg8::Gemm g{WS_PTR(const pg8::bf16_t, WS_CQN), WS_PTR(const pg8::bf16_t, WS_WT) + l * WT_LAYER + WT_UQ, T, 1536, 512};
        pg8::StaticOrder so; so.init(T, 1536, G, bx);
        pg8::EpiBf16S ep{WS_PTR(pg8::bf16_t, WS_QMLA), 1536, WS_PTR(const float, WS_SSQ)};
        pg8::gemm_phase((PG8_LAS unsigned char*)lds, g, so, ep);
    }
    {
        pg8::Gemm g{WS_PTR(const pg8::bf16_t, WS_CKVN), WS_PTR(const pg8::bf16_t, WS_WT) + l * WT_LAYER + WT_UKV, T, 2048, 256};
        pg8::StaticOrder so; so.init(T, 2048, G, (bx + 192) % G);
        pg8::EpiKV ep{WS_PTR(pg8::bf16_t, WS_KMLA), WS_PTR(pg8::bf16_t, WS_VMLA), WS_PTR(const float, WS_SSQ)};
        pg8::gemm_phase((PG8_LAS unsigned char*)lds, g, so, ep);
    }
    phase_cmp1(p, lds, l, bx);
}
__device__ __forceinline__ void phase_cmp2(const Params& p, char* lds, const int l) {
    const int tid = TID(); float* hid = (float*)lds;
    for (int u = blockIdx.x; u < 2 * 127; u += gridDim.x) {
        const int which = u / 127, r0 = (u - which * 127) * 8;
        const float* bias = WS_PTR(const float, WS_BIAS1) + (l * 2 + which) * 512;
        __syncthreads();
#pragma unroll
        for (int i = 0; i < 8; ++i) { const int e = tid + i * 512, r = e >> 9, c = e & 511; float a = bias[c];
#pragma unroll
            for (int ks = 0; ks < 4; ++ks) a += WS_PTR(const float, WS_CMP1P)[((long)(ks * 2 + which) * 1024 + r0 + r) * 512 + c];
            hid[e] = gelu_tanh(a); }
        __syncthreads();
        const int col = tid & 127, rp = tid >> 7; const float* w2 = (which ? p.w_cv2 : p.w_ck2) + (long)l * 512 * 128 + col;
        float a0 = 0.f, a1 = 0.f;
#pragma unroll 8
        for (int k = 0; k < 512; ++k) { const float w = w2[k * 128]; a0 += hid[(rp * 2) * 512 + k] * w; a1 += hid[(rp * 2 + 1) * 512 + k] * w; }
        bf16* outp = WS_PTR(bf16, WS_KCMP) + (long)which * 8 * 128 * 128;
#pragma unroll
        for (int q = 0; q < 2; ++q) { const int R = r0 + rp * 2 + q; if (R < CMP_ROWS) { const int bg = R / NCMP, c = R - bg * NCMP;
            outp[((long)bg * 128 + c) * 128 + col] = __float2bfloat16(q ? a1 : a0); } }
    }
}
__device__ __forceinline__ void phase_attn_mla(const Params& p, char* lds, const int l, const int dup) {
    const int tid = TID();
    volatile int* slot = (volatile int*)(lds + L_MISC);
    int* qc = WS_PTR(int, CTL_Q) + l * 2 + dup * 4;
    for (;;) {
        __syncthreads();
        if (tid == 0) slot[0] = atomicAdd(qc, 1);
        __syncthreads();
        const int qi = slot[0]; if (qi >= 256) break;
        mla_unit(p, lds, (qi & 31) >> 3, qi & 7, 7 - (qi >> 5));
    }
}
__device__ __forceinline__ void phase_attn_nsa(const Params& p, char* lds, const int l, const int dup) {
    const int tid = TID();
    {
        for (int i = tid; i < 2 * 64 * 32; i += NTHR) { const int tt = i >> 11, k = (i >> 5) & 63, n = i & 31, c = tt * 64 + k;
            const bool ov = (c * 16 <= n * 64 + 63) && (c * 16 + 31 >= n * 64);
            const int kk = (k & ~0xC) | ((k & 4) << 1) | ((k & 8) >> 1);
            *(unsigned short*)(lds + L_OV + tt * 4096 + (kk >> 3) * 512 + ((kk & 7) * 32 + n) * 2) = ov ? 0x3F80 : 0; }
    }
    volatile int* slot = (volatile int*)(lds + L_MISC);
    int* qc = WS_PTR(int, CTL_Q) + l * 2 + dup * 4;
    for (;;) {
        __syncthreads();
        if (tid == 0) slot[0] = atomicAdd(qc + 1, 1);
        __syncthreads();
        const int qi = slot[0]; if (qi >= 256) break;
        nsa_unit(p, lds, (qi & 7) >> 1, qi & 1, 31 - (qi >> 3));
    }
}
__device__ __forceinline__ void phase_xattn(const Params& p, char* lds, const int l) {
    for (int u = blockIdx.x; u < 128; u += gridDim.x) xattn_unit(p, lds, l, u >> 5, (u >> 3) & 3, u & 7);
}
__device__ __forceinline__ void phase_router(const Params& p, char* lds, const int l) {
    for (int u = blockIdx.x; u < T / 128; u += gridDim.x) {
        row_inv_to_lds(lds, WS_PTR(const float, WS_HSSQ), u * 128);
        ARowsPlain af{WS_PTR(const bf16, WS_HB), DM, u * 128, T};
        BRouter bf{p.w_grp + (long)l * DM * 8, p.w_exp + (long)l * DM * 64, nullptr};
        HEpiRouter ef{lds, p.b_grp + l * 8, p.b_exp + l * 64, WS_PTR(int, CTL_CNT) + l * 64, WS_PTR(int, WS_TOKE), WS_PTR(int, WS_TOKR),
                     WS_PTR(int, WS_ELIST), WS_PTR(float, WS_EGATE), WS_PTR(float, WS_EINV), u * 128};
        hgemm1_tile(lds, DM / 64, af, bf, ef);
    }
}
__device__ __forceinline__ int moe_find(const int* toff, const int tile) { int e = 0;
#pragma unroll 1
    for (int s = 32; s > 0; s >>= 1) if (toff[e + s] <= tile) e += s; return e; }
template <int NCH, class F>
__device__ __forceinline__ void moe_xcd_queues(char* lds, int* heads, const int ngrp, const F& body) {
    volatile int* slot = (volatile int*)(lds + L_MISC);
    const int my = (int)(xb_xcc_id() & 7u), tid = TID();
    for (int sft = 0; sft < 8; ++sft) {
        const int q = (my + sft) & 7, nq = q < ngrp ? (ngrp - q + 7) >> 3 : 0;
        for (;;) {
            __syncthreads();
            if (tid == 0) slot[0] = atomicAdd(heads + q * 16, 1);
            __syncthreads();
            const int i = slot[0]; if (i >= nq * NCH) break;
            body(q + 8 * (i / NCH), i % NCH);
        }
    }
}
template <int VAR> __device__ __forceinline__ void phase_moe1(const Params& p, char* lds, const int l, const int dup) {
    moe_prefix(p, lds, l);
    const int* offs = (const int*)(lds + L_PFX); const int* toff = offs + 65; const int* cnt = WS_PTR(const int, CTL_CNT) + l * 64;
    moe_xcd_queues<8>(lds, WS_PTR(int, CTL_XQ) + ((l * 2 + 0) * 2 + dup) * 128, toff[64], [&](const int grp, const int ch) {
        const int e = moe_find(toff, grp); const int r0 = (grp - toff[e]) * 384, c = cnt[e];
        const int rows = (c - r0) < 384 ? (c - r0) : 384;
        AVGather af{WS_PTR(const bf16, WS_HB), WS_PTR(const int, WS_ELIST) + e * ECAP, r0, c};
        BVGateUp bf{p.w_e1 + ((long)l * NEXP + e) * DM * 512, p.w_e3 + ((long)l * NEXP + e) * DM * 512, ch * 64, nullptr};
        EVMoe1S ef{(VAR ? WS_PTR(bf16, WS_PROJ) : WS_PTR(bf16, WS_HBUF)) + (long)(offs[e] + r0) * 512, WS_PTR(const float, WS_EINV) + e * ECAP + r0, ch * 64, rows, lds};
        { const int nb_ = (rows + 127) >> 7;
          if (VAR == 0) { if (nb_ >= 3) hgemm_tile<3>(lds, DM / 64, af, bf, ef); else if (nb_ == 2) hgemm_tile<2>(lds, DM / 64, af, bf, ef); else hgemm_tile<1>(lds, DM / 64, af, bf, ef); }
          else vgemm_tile_n<VAR, 0>(lds, DM / 64, nb_, af, bf, ef); }
    });
}
template <int VAR> __device__ __forceinline__ void phase_moe2(const Params& p, char* lds, const int l, const int dup) {
    moe_prefix(p, lds, l);
    const int* offs = (const int*)(lds + L_PFX); const int* toff = offs + 65; const int* cnt = WS_PTR(const int, CTL_CNT) + l * 64;
    moe_xcd_queues<16>(lds, WS_PTR(int, CTL_XQ) + ((l * 2 + 1) * 2 + dup) * 128, toff[64], [&](const int grp, const int ch) {
        const int e = moe_find(toff, grp); const int r0 = (grp - toff[e]) * 384, c = cnt[e];
        const int rows = (c - r0) < 384 ? (c - r0) : 384;
        AVPlain af{WS_PTR(const bf16, WS_HBUF) + (long)(offs[e] + r0) * 512, 512, rows};
        BVPlain bf{p.w_e2 + ((long)l * NEXP + e) * 512 * DM, DM, ch * 128, nullptr};
        EVMoe2S ef{(VAR ? WS_PTR(bf16, WS_PROJ) : WS_PTR(bf16, WS_YBUF)) + (long)(offs[e] + r0) * DM, WS_PTR(const float, WS_EGATE) + e * ECAP + r0, ch * 128, rows, lds};
        { const int nb_ = (rows + 127) >> 7;
          if (VAR == 0) { if (nb_ >= 3) hgemm_tile<3>(lds, 512 / 64, af, bf, ef); else if (nb_ == 2) hgemm_tile<2>(lds, 512 / 64, af, bf, ef); else hgemm_tile<1>(lds, 512 / 64, af, bf, ef); }
          else vgemm_tile_n<VAR, 0>(lds, 512 / 64, nb_, af, bf, ef); }
    });
}

#if defined(__HIP_DEVICE_COMPILE__)
#define PHASE_LOADP() const Params __attribute__((address_space(4)))* pp_ = (const Params __attribute__((address_space(4)))*)__builtin_amdgcn_kernarg_segment_ptr(); \
    asm volatile("" : "+s"(pp_)); Params p; PFIELDS(PHASE_LDF) p.ph_lo = 0; p.ph_hi = 0;
#else
#define PHASE_LOADP() Params p{};
#endif
#define PHASE_LDF(f) p.f = pp_->f;
#define PHASE_FN(name) static __device__ __forceinline__ void name(char* lds, const int l, const int dup) { (void)l; (void)lds; (void)dup; PHASE_LOADP()
#define PHASE_END }
PHASE_FN(ph_norm0)
    bf16* h = WS_PTR(bf16, WS_H);
    if (l == 0) {
        norm_rows<false>(p, p.x, T, p.g_mix, WS_PTR(bf16, WS_XN), nullptr, nullptr, nullptr);
        norm_rows<false>(p, p.mem, 1024, p.g_mem, WS_PTR(bf16, WS_MEMN), nullptr, nullptr, nullptr);
        prologue_misc(p, lds);
        prologue_weights(p, lds, 0, 0, gridDim.x);
    } else {
        moe_prefix(p, lds, l - 1);
        norm_rows<true, true>(p, h, T, p.g_mix + l * DM, WS_PTR(bf16, WS_XN), nullptr, dup ? nullptr : h, (const int*)(lds + L_PFX));
    }
PHASE_END
PHASE_FN(ph_inproj) phase_inproj(p, lds, l); PHASE_END
PHASE_FN(ph_post) phase_post(p, l); PHASE_END
PHASE_FN(ph_upproj) phase_upproj(p, lds, l); PHASE_END
PHASE_FN(ph_cmp2) phase_cmp2(p, lds, l); PHASE_END
PHASE_FN(ph_attn) phase_attn_mla(p, lds, l, dup); phase_attn_nsa(p, lds, l, dup); PHASE_END
PHASE_FN(ph_combine) phase_combine(p, l); PHASE_END
PHASE_FN(ph_outproj)
    pg8::bf16_t* h = WS_PTR(pg8::bf16_t, WS_H);
    pg8::Gemm g{WS_PTR(const pg8::bf16_t, WS_Y), WS_PTR(const pg8::bf16_t, WS_WT) + l * WT_LAYER + WT_OUT, T, DM, DM};
    pg8::StaticOrder so; so.init(T, DM, gridDim.x, blockIdx.x);
    {
        pg8::Unit u0; const int tid = TID();
        if (so.next(0, u0) && tid < 256) { const float* ys = WS_PTR(const float, WS_YSSQ) + (long)(u0.pm * 256 + tid) * 16;
            const f32x4 a0 = *(const f32x4*)ys, a1 = *(const f32x4*)(ys + 4), b0 = *(const f32x4*)(ys + 8), b1 = *(const f32x4*)(ys + 12);
            const float ia = rsqrtf((((a0[0] + a0[1]) + (a0[2] + a0[3])) + ((a1[0] + a1[1]) + (a1[2] + a1[3]))) * (1.f / 1024.f) + 1e-6f);
            const float ib = rsqrtf((((b0[0] + b0[1]) + (b0[2] + b0[3])) + ((b1[0] + b1[1]) + (b1[2] + b1[3]))) * (1.f / 1024.f) + 1e-6f);
            ((float*)(lds + L_YSC))[tid] = ia / ib; ((float*)(lds + L_YSC))[256 + tid] = ib; }
        __syncthreads();
    }
    if (l == 0) { pg8::EpiResHT<false> ep{dup ? WS_PTR(pg8::bf16_t, WS_PROJ) : h, p.x, dup ? WS_PTR(pg8::bf16_t, WS_XN) : WS_PTR(pg8::bf16_t, WS_HB), WS_PTR(float, WS_HSSQ), (const float*)(lds + L_YSC), p.g_x + l * DM, DM};
        pg8::gemm_phase((PG8_LAS unsigned char*)lds, g, so, ep); }
    else { pg8::EpiResHT<true> ep{dup ? WS_PTR(pg8::bf16_t, WS_PROJ) : h, h, dup ? WS_PTR(pg8::bf16_t, WS_XN) : WS_PTR(pg8::bf16_t, WS_HB), WS_PTR(float, WS_HSSQ), (const float*)(lds + L_YSC), p.g_x + l * DM, DM};
        pg8::gemm_phase((PG8_LAS unsigned char*)lds, g, so, ep); }
PHASE_END
PHASE_FN(ph_qx)
    bf16* qx = WS_PTR(bf16, WS_QX);
    for (int u = blockIdx.x; u < (T / 128) * 4; u += gridDim.x) {
        const int mt = u >> 2, nt = u & 3;
        row_inv_to_lds(lds, WS_PTR(const float, WS_HSSQ), mt * 128);
        ARowsPlain af{WS_PTR(const bf16, WS_HB), DM, mt * 128, T}; BPlain bf{p.w_xq + (long)l * DM * 512, 512, nt * 128, 512, nullptr};
        hgemm1_tile(lds, DM / 64, af, bf, HEpiBf16{qx, 512, mt * 128, nt * 128, T, (const float*)(lds + L_RINV)});
    }
PHASE_END
PHASE_FN(ph_xattn) phase_xattn(p, lds, l); PHASE_END
PHASE_FN(ph_xo)
    pg8::bf16_t* h = WS_PTR(pg8::bf16_t, WS_H);
    pg8::Gemm g{WS_PTR(const pg8::bf16_t, WS_OX), WS_PTR(const pg8::bf16_t, WS_WT) + l * WT_LAYER + WT_XO, T, DM, 512};
    pg8::StaticOrder so; so.init(T, DM, gridDim.x, blockIdx.x);
    pg8::EpiResHT<true> ep{dup ? WS_PTR(pg8::bf16_t, WS_PROJ) : h, h, dup ? WS_PTR(pg8::bf16_t, WS_XN) : WS_PTR(pg8::bf16_t, WS_HB), WS_PTR(float, WS_HSSQ), nullptr, p.g_ffn + l * DM, DM};
    pg8::gemm_phase((PG8_LAS unsigned char*)lds, g, so, ep);
PHASE_END
PHASE_FN(ph_router) if (!dup) { phase_router(p, lds, l); if (l == 0) prologue_weights(p, lds, 1, 64, gridDim.x - 64); } PHASE_END
PHASE_FN(ph_moe1) if (dup && PROBE_VAR) phase_moe1<PROBE_VAR>(p, lds, l, dup); else phase_moe1<0>(p, lds, l, dup); PHASE_END
PHASE_FN(ph_moe2) if (dup && PROBE_VAR) phase_moe2<PROBE_VAR>(p, lds, l, dup); else phase_moe2<0>(p, lds, l, dup); PHASE_END
PHASE_FN(ph_final)
    moe_prefix(p, lds, DEPTH - 1);
    norm_rows<true, true>(p, WS_PTR(const bf16, WS_H), T, p.g_final, nullptr, p.out, nullptr, (const int*)(lds + L_PFX));
PHASE_END

constexpr int NPH_LAYER = 12;
constexpr int NPH = DEPTH * NPH_LAYER + 1;
#if defined(__HIP_DEVICE_COMPILE__)
#define KARG(f) ({ const Params __attribute__((address_space(4)))* q_ = (const Params __attribute__((address_space(4)))*)__builtin_amdgcn_kernarg_segment_ptr(); asm volatile("" : "+s"(q_)); q_->f; })
#else
#define KARG(f) (p.f)
#endif
__global__ void __launch_bounds__(NTHR, 2) fwd(const Params p) {
    extern __shared__ __attribute__((aligned(16))) char lds[];
    {
        const int tid = TID();
        if (tid < 64) ((volatile unsigned*)(lds + L_MISC))[tid] = 0u;
        __syncthreads();
        if (KARG(ph_hi) - KARG(ph_lo) > 1) (void)xcd_barrier_post((unsigned*)(KARG(ws) + WS_CTL), (volatile LAS unsigned*)(lds + L_MISC + 16));
    }
    int ph = 0;
#define BARRIER() do { XcdBarrier bar_; bar_.bar = (unsigned*)(KARG(ws) + WS_CTL); bar_.x = xb_xcc_id(); bar_.st = (volatile LAS unsigned*)(lds + L_MISC + 16); \
        xcd_barrier(bar_); if (PROBE_BAR2) xcd_barrier(bar_); } while (0)
#define RUN(k, fn, l_) do { if (KARG(ph_lo) <= ph && ph < KARG(ph_hi)) { fn(lds, (l_), 0); if ((PROBE_MASK >> (k)) & 1) { BARRIER(); fn(lds, (l_), 1); } if (ph + 1 < KARG(ph_hi)) BARRIER(); } ++ph; } while (0)
#define LAYER(l) do { \
    RUN(0, ph_norm0, l); \
    RUN(1, ph_inproj, l); \
    RUN(3, ph_upproj, l); \
    RUN(4, ph_cmp2, l); \
    RUN(5, ph_attn, l); \
    RUN(8, ph_outproj, l); \
    RUN(10, ph_qx, l); \
    RUN(11, ph_xattn, l); \
    RUN(12, ph_xo, l); \
    RUN(14, ph_router, l); \
    RUN(15, ph_moe1, l); \
    RUN(16, ph_moe2, l); \
    } while (0)
    static_assert(DEPTH == 2, "layer program written out twice");
    LAYER(0); LAYER(1);
#undef LAYER
    RUN(17, ph_final, 0);
#undef RUN
#undef BARRIER
}

extern "C" void kernel_launch(void* const* d_in, const int* in_sizes, int n_in, void* d_out, int out_size, void* d_ws, size_t ws_size, hipStream_t stream) {
    static int grid = 0;
    if (grid == 0) {
        if (n_in != 32 || in_sizes[0] != T * DM || out_size != T * DM || ws_size < WS_END) {
            fprintf(stderr, "kernel_launch: shape mismatch n_in %d in0 %d out %d ws %zu (need %zu)\n", n_in, n_in > 0 ? in_sizes[0] : -1, out_size, ws_size, (size_t)WS_END); grid = -1; return; }
        int dev = 0, cus = 0, per_cu = 0;
        if (hipGetDevice(&dev) != hipSuccess || hipDeviceGetAttribute(&cus, hipDeviceAttributeMultiprocessorCount, dev) != hipSuccess) { grid = -1; return; }
        if (hipFuncSetAttribute((const void*)fwd, hipFuncAttributeMaxDynamicSharedMemorySize, LDS_BYTES) != hipSuccess) { fprintf(stderr, "kernel_launch: hipFuncSetAttribute failed\n"); grid = -1; return; }
        if (hipOccupancyMaxActiveBlocksPerMultiprocessor(&per_cu, (const void*)fwd, NTHR, LDS_BYTES) != hipSuccess || per_cu < 1)
            fprintf(stderr, "kernel_launch: occupancy query reports %d\n", per_cu);
        (void)hipGetLastError();
        if (cus < 256) { fprintf(stderr, "kernel_launch: built for a 256-CU device (got %d)\n", cus); grid = -1; return; }
        grid = cus;
    }
    if (grid < 0) return;
    (void)hipMemsetAsync((char*)d_ws + WS_CTL, 0, CTL_BYTES, stream);
    Params p{};
    const float* const* f = (const float* const*)d_in;
    p.x = f[0]; p.mem = f[1]; p.positions = (const int*)d_in[2];
    p.g_mem = f[3]; p.g_final = f[4]; p.g_mix = f[5]; p.w_in = f[6]; p.g_cq = f[7]; p.w_uq = f[8]; p.g_ckv = f[9]; p.w_ukv = f[10];
    p.pe_k = f[11]; p.pe_v = f[12]; p.w_ck1 = f[13]; p.w_ck2 = f[14]; p.w_cv1 = f[15]; p.w_cv2 = f[16]; p.g_ya = f[17]; p.g_yb = f[18];
    p.w_out = f[19]; p.g_x = f[20]; p.w_xq = f[21]; p.w_xkv = f[22]; p.w_xo = f[23]; p.g_ffn = f[24]; p.w_grp = f[25]; p.b_grp = f[26];
    p.w_exp = f[27]; p.b_exp = f[28]; p.w_e1 = f[29]; p.w_e3 = f[30]; p.w_e2 = f[31];
    p.out = (float*)d_out; p.ws = (unsigned char*)d_ws;
#if MK_FUSED
    p.ph_lo = 0; p.ph_hi = NPH;
    hipLaunchKernelGGL(fwd, dim3(grid), dim3(NTHR), LDS_BYTES, stream, p);
#else
    for (int ph = 0; ph < NPH; ++ph) { p.ph_lo = ph; p.ph_hi = ph + 1; hipLaunchKernelGGL(fwd, dim3(grid), dim3(NTHR), LDS_BYTES, stream, p); }
#endif
    const hipError_t le = hipPeekAtLastError();
    if (le != hipSuccess) fprintf(stderr, "kernel_launch: launch failed: %s\n", hipGetErrorName(le));
}
```
